# Optimizing an MI355X kernel written in HIP

```python
import math
import jax, jax.numpy as jnp
from jax import lax
import numpy as np

D_MODEL = 1024
BATCH = 2
SEQ = 16384
DEPTH = 2

CHUNK = 64
QBLK = 128
FOX_HEADS = 8
FOX_HEAD_DIM = 64
FOX_WIDTH = FOX_HEADS * FOX_HEAD_DIM
DIFF_HEADS = 4
DIFF_HEAD_DIM = 64
DIFF_V_DIM = 2 * DIFF_HEAD_DIM
DIFF_WIDTH = DIFF_HEADS * DIFF_V_DIM
DIFF_QK_WIDTH = DIFF_HEADS * 2 * DIFF_HEAD_DIM
MIX_WIDTH = FOX_WIDTH + DIFF_WIDTH
IN_COLS = 3 * FOX_WIDTH + FOX_HEADS + 2 * DIFF_QK_WIDTH + DIFF_WIDTH
D_FF = 4 * D_MODEL
N_BUCKETS = 32
MAX_DISTANCE = 128
NORM_EPS = 1e-5
SUBLN_EPS = 1e-5
FORGET_BIAS_INIT = 4.0

kernel_name = "hymba_fox_diffattn_sqrelu_trunk"


def rmsnorm(x, g, eps=NORM_EPS):
    xf = x.astype(jnp.float32)
    y = xf * lax.rsqrt(jnp.mean(xf * xf, axis=-1, keepdims=True) + eps)
    return (y * g.astype(jnp.float32)).astype(x.dtype)


def t5_bucket(rel):
    half = N_BUCKETS // 2
    max_exact = half // 2
    ret = jnp.where(rel > 0, half, 0)
    n = jnp.abs(rel)
    nf = jnp.maximum(n, 1).astype(jnp.float32)
    large = max_exact + (jnp.log(nf / max_exact) / math.log(MAX_DISTANCE / max_exact)
                         * (half - max_exact)).astype(jnp.int32)
    large = jnp.minimum(large, half - 1)
    return ret + jnp.where(n < max_exact, n, large)


def to_blocks(t):
    b, h, s = t.shape[:3]
    t = t.reshape((b, h, s // QBLK, QBLK) + t.shape[3:])
    return jnp.moveaxis(t, 2, 0)


def from_blocks(t):
    nb, b, h, qb, d = t.shape
    return jnp.moveaxis(t, 0, 2).reshape(b, h, nb * qb, d)


def fox_attention(q, k, v, logf):
    s_len = q.shape[2]
    scale = 1.0 / math.sqrt(q.shape[-1])
    c = jnp.cumsum(logf, axis=-1)
    kpos = jnp.arange(s_len)
    nb = s_len // QBLK

    def body(args):
        i, qb, cb = args
        qpos = i * QBLK + jnp.arange(QBLK)
        s = jnp.einsum('bhqd,bhkd->bhqk', qb, k).astype(jnp.float32) * scale
        s = s + cb[..., :, None] - c[..., None, :]
        mask = kpos[None, :] <= qpos[:, None]
        s = jnp.where(mask, s, -jnp.inf)
        p = jax.nn.softmax(s, axis=-1)
        return jnp.einsum('bhqk,bhkd->bhqd', p.astype(v.dtype), v)

    out = lax.map(body, (jnp.arange(nb), to_blocks(q), to_blocks(c)))
    return from_blocks(out)


def diff_attention(q1, q2, k1, k2, v, lam, table):
    s_len = q1.shape[2]
    scale = 1.0 / math.sqrt(q1.shape[-1])
    kpos = jnp.arange(s_len)
    nb = s_len // QBLK
    tab = table.astype(jnp.float32)

    def body(args):
        i, q1b, q2b = args
        qpos = i * QBLK + jnp.arange(QBLK)
        rel = kpos[None, :] - qpos[:, None]
        bias = jnp.moveaxis(tab[t5_bucket(rel)], -1, 0)
        mask = (kpos // CHUNK)[None, :] <= (qpos // CHUNK)[:, None]

        def probs(qb, kk):
            s = jnp.einsum('bhqd,bhkd->bhqk', qb, kk).astype(jnp.float32) * scale + bias
            return jax.nn.softmax(jnp.where(mask, s, -jnp.inf), axis=-1)

        p = probs(q1b, k1) - lam * probs(q2b, k2)
        return jnp.einsum('bhqk,bhkd->bhqd', p.astype(v.dtype), v)

    out = lax.map(body, (jnp.arange(nb), to_blocks(q1), to_blocks(q2)))
    return from_blocks(out)


def setup_inputs(seed: int = 0) -> dict:
    key = jax.random.key(seed)
    ks = jax.random.split(key, 16)
    nrm = jax.random.normal
    f32 = jnp.float32
    return {
        "x": nrm(ks[0], (BATCH, SEQ, D_MODEL), f32),
        "w_in": nrm(ks[1], (DEPTH, D_MODEL, IN_COLS), f32) * D_MODEL ** -0.5,
        "b_f": FORGET_BIAS_INIT + 0.1 * nrm(ks[2], (DEPTH, FOX_HEADS), f32),
        "lambda_q1": 0.1 * nrm(ks[3], (DEPTH, DIFF_HEAD_DIM), f32),
        "lambda_k1": 0.1 * nrm(ks[4], (DEPTH, DIFF_HEAD_DIM), f32),
        "lambda_q2": 0.1 * nrm(ks[5], (DEPTH, DIFF_HEAD_DIM), f32),
        "lambda_k2": 0.1 * nrm(ks[6], (DEPTH, DIFF_HEAD_DIM), f32),
        "subln_g": 1.0 + 0.02 * nrm(ks[7], (DEPTH, DIFF_V_DIM), f32),
        "w_out": nrm(ks[8], (DEPTH, MIX_WIDTH, D_MODEL), f32) * MIX_WIDTH ** -0.5,
        "norm_attn_g": 1.0 + 0.02 * nrm(ks[9], (DEPTH, D_MODEL), f32),
        "norm_mlp_g": 1.0 + 0.02 * nrm(ks[10], (DEPTH, D_MODEL), f32),
        "w_mlp_in": nrm(ks[11], (DEPTH, D_MODEL, D_FF), f32) * D_MODEL ** -0.5,
        "w_mlp_out": nrm(ks[12], (DEPTH, D_FF, D_MODEL), f32) * D_FF ** -0.5,
        "rel_bias_table": 0.5 * nrm(ks[13], (N_BUCKETS, DIFF_HEADS), f32),
        "final_norm_g": 1.0 + 0.02 * nrm(ks[14], (D_MODEL,), f32),
    }


def reference(x, w_in, b_f, lambda_q1, lambda_k1, lambda_q2, lambda_k2, subln_g,
              w_out, norm_attn_g, norm_mlp_g, w_mlp_in, w_mlp_out,
              rel_bias_table, final_norm_g):
    B, S, _ = x.shape
    splits = np.cumsum([FOX_WIDTH, FOX_WIDTH, FOX_WIDTH, FOX_HEADS,
                        DIFF_QK_WIDTH, DIFF_QK_WIDTH])

    def heads(t, h):
        return t.reshape(B, S, h, -1).transpose(0, 2, 1, 3)

    for l in range(DEPTH):
        h = rmsnorm(x, norm_attn_g[l])
        z = h @ w_in[l]
        fq, fk, fv, ff, dq, dk, dv = jnp.split(z, splits, axis=-1)

        logf = jax.nn.log_sigmoid(ff.astype(jnp.float32) + b_f[l].astype(jnp.float32))
        logf = logf.transpose(0, 2, 1)
        fox_out = fox_attention(heads(fq, FOX_HEADS), heads(fk, FOX_HEADS),
                                heads(fv, FOX_HEADS), logf)
        fox_out = fox_out.transpose(0, 2, 1, 3).reshape(B, S, FOX_WIDTH)

        dq = dq.reshape(B, S, DIFF_HEADS, 2, DIFF_HEAD_DIM)
        dk = dk.reshape(B, S, DIFF_HEADS, 2, DIFF_HEAD_DIM)
        q1 = dq[..., 0, :].transpose(0, 2, 1, 3)
        q2 = dq[..., 1, :].transpose(0, 2, 1, 3)
        k1 = dk[..., 0, :].transpose(0, 2, 1, 3)
        k2 = dk[..., 1, :].transpose(0, 2, 1, 3)
        vv = heads(dv, DIFF_HEADS)
        lambda_init = 0.8 - 0.6 * math.exp(-0.3 * l)
        lam = (jnp.exp(jnp.sum(lambda_q1[l].astype(jnp.float32) * lambda_k1[l].astype(jnp.float32)))
               - jnp.exp(jnp.sum(lambda_q2[l].astype(jnp.float32) * lambda_k2[l].astype(jnp.float32)))
               + lambda_init)
        d_out = diff_attention(q1, q2, k1, k2, vv, lam, rel_bias_table)
        d_out = rmsnorm(d_out, subln_g[l], SUBLN_EPS) * (1.0 - lambda_init)
        d_out = d_out.transpose(0, 2, 1, 3).reshape(B, S, DIFF_WIDTH)

        mixed = jnp.concatenate([fox_out, d_out], axis=-1)
        x = x + mixed @ w_out[l]

        h = rmsnorm(x, norm_mlp_g[l])
        x = x + jnp.square(jax.nn.relu(h @ w_mlp_in[l])) @ w_mlp_out[l]

    return rmsnorm(x, final_norm_g)
```

```cpp
#include <hip/hip_runtime.h>
#include <cstdio>
#include <cstdint>
__device__ __forceinline__ float shx(float v, int k, int lane) { return __builtin_bit_cast(float, __builtin_amdgcn_ds_bpermute((lane ^ k) << 2, __builtin_bit_cast(int, v))); }
__device__ __forceinline__ float shl_(float v, int src, int lane) { (void)lane; return __builtin_bit_cast(float, __builtin_amdgcn_ds_bpermute(src << 2, __builtin_bit_cast(int, v))); }
namespace pg8 {
#define PG8_LAS __attribute__((address_space(3)))
typedef unsigned short bf16_t;
typedef short bf16x8 __attribute__((ext_vector_type(8)));
typedef float f32x4 __attribute__((ext_vector_type(4)));
typedef unsigned u32x4 __attribute__((ext_vector_type(4)));
constexpr int BM = 256, BK = 64, HALF = 128, HTB = HALF * BK * 2  , STAGE_BYTES = 8 * HTB, NXCD = 8, WGM = 8;

__host__ __device__ __forceinline__ int lds_byte(int r, int c) { const int st = (r >> 4) * 2 + (c >> 5), rr = r & 15, cc = c & 31, ob = rr * 64 + cc * 2; return st * 1024 + (ob ^ (((ob >> 9) & 1) << 5)); }
__host__ __device__ __forceinline__ void stage_rc(int b, int& R, int& C) { const int st = b / 1024, sb = b % 1024, swz = sb ^ (((sb >> 9) & 1) << 5); R = (st >> 1) * 16 + swz / 64; C = (st & 1) * 32 + (swz % 64) / 2; }
__host__ __device__ __forceinline__ int perm32(int rho) { const int n = rho >> 4, i = rho & 15; return 8 * (i >> 2) + 4 * n + (i & 3); }

struct Unit { int pm, pn; };
struct Gemm { const bf16_t* A; const bf16_t* Bt; int M, N, K; };

struct StaticOrder {
    int nM, nN, nwg, G, c;
    __host__ __device__ void init(int M, int N, int G_, int c_) { nM = M / BM; nN = N / BM; nwg = nM * nN; G = G_; c = c_; }
    __host__ __device__ bool next(int i, Unit& u) const {
        const long L = (long)i * G + c; if (L >= nwg) return false;
        int wgid = (int)L; { const int q = nwg / NXCD, r = nwg % NXCD, xcd = wgid % NXCD, off = wgid / NXCD; wgid = (xcd < r ? xcd * (q + 1) : r * (q + 1) + (xcd - r) * q) + off; }
        const int nig = WGM * nN, gid = wgid / nig, fm = gid * WGM, gsz = (nM - fm) < WGM ? (nM - fm) : WGM;
        u.pm = fm + ((wgid % nig) % gsz); u.pn = (wgid % nig) / gsz; return true;
    }
    __device__ __forceinline__ void a_ready(const Unit&) const {}
    __device__ __forceinline__ void done(const Unit&) const {}
};

__device__ __forceinline__ unsigned cvt_pk_bf16(float lo, float hi) { unsigned r; asm volatile("v_cvt_pk_bf16_f32 %0, %1, %2" : "=v"(r) : "v"(lo), "v"(hi)); return r; }
typedef float f32x2 __attribute__((ext_vector_type(2)));
typedef unsigned u32x2 __attribute__((ext_vector_type(2)));
constexpr float QC2 = 0.125f * 1.4426950408889634f;
constexpr int ZPITCH = 3072, SEQ_ = 16384;
__device__ __forceinline__ float row_rstd(const float* ssq, int row) {
    const f32x4 q = *(const f32x4*)(ssq + (size_t)row * 4); return 1.0f / sqrtf(((q[0] + q[1]) + (q[2] + q[3])) * (1.0f / 1024.0f) + 1e-5f);
}
struct EpiInProj {
    static constexpr bool PERM = true, AFTER_DRAIN = false;
    bf16_t* Z; const PG8_LAS float* rtab;     const float* ssq; const float* bf; float* logf2; unsigned* nrm;
    __device__ __forceinline__ void operator()(const f32x4 (&acc)[2][2][4][2], const Unit& u, int wr, int wc, int fr, int fq, int ui) const {
        const int row0 = u.pm * BM + wr * 64 + fr;
        float rs[2][4];
#pragma unroll
        for (int ai = 0; ai < 2; ++ai)
#pragma unroll
            for (int m = 0; m < 4; ++m) rs[ai][m] = rtab[ui * 256 + wr * 64 + fr + ai * HALF + m * 16];
        if (u.pn < 12) {
            const float sc = (u.pn < 2 || u.pn == 6 || u.pn == 7) ? QC2 : 1.f;
            const int col0 = u.pn * BM + wc * 32 + 8 * fq;
#pragma unroll
            for (int ai = 0; ai < 2; ++ai)
#pragma unroll
                for (int m = 0; m < 4; ++m) { bf16_t* rowp = Z + (size_t)(row0 + ai * HALF + m * 16) * ZPITCH + col0; const float s = rs[ai][m] * sc;
#pragma unroll
                    for (int bj = 0; bj < 2; ++bj) { const f32x4 v0 = acc[ai][bj][m][0] * s, v1 = acc[ai][bj][m][1] * s; u32x4 w;
                        w.x = cvt_pk_bf16(v0[0], v0[1]); w.y = cvt_pk_bf16(v0[2], v0[3]); w.z = cvt_pk_bf16(v1[0], v1[1]); w.w = cvt_pk_bf16(v1[2], v1[3]);
                        *(u32x4*)(rowp + bj * HALF) = w; } }
            if ((u.pn >= 2 && u.pn < 4) || (u.pn >= 6 && u.pn < 10)) {
                const int which = u.pn < 4 ? (u.pn >> 1) : 2 + ((u.pn - 6) >> 1);
                float mx[2] = {0.f, 0.f};
#pragma unroll
                for (int ai = 0; ai < 2; ++ai)
#pragma unroll
                    for (int m = 0; m < 4; ++m) { const float s = rs[ai][m] * sc;
#pragma unroll
                        for (int bj = 0; bj < 2; ++bj) { const f32x4 v0 = acc[ai][bj][m][0] * s, v1 = acc[ai][bj][m][1] * s;
                            float p = (v0[0] * v0[0] + v0[1] * v0[1]) + (v0[2] * v0[2] + v0[3] * v0[3]) + (v1[0] * v1[0] + v1[1] * v1[1]) + (v1[2] * v1[2] + v1[3] * v1[3]);
                            p += shx(p, 16, fr + 16 * fq); p += shx(p, 32, fr + 16 * fq); mx[bj] = fmaxf(mx[bj], p); } }
#pragma unroll
                for (int bj = 0; bj < 2; ++bj) { float m = mx[bj]; { const int ln = fr + 16 * fq; m = fmaxf(m, shx(m, 1, ln)); m = fmaxf(m, shx(m, 2, ln)); m = fmaxf(m, shx(m, 4, ln)); m = fmaxf(m, shx(m, 8, ln)); }
                    if (fr == 0 && fq == 0) atomicMax(nrm + (((which * 2 + (u.pm >> 6)) * 8 + (u.pn & 1) * 4 + bj * 2 + (wc >> 1)) * 2 + (wc & 1)), __float_as_uint(m)); }
            }
        } else if (wc == 0 && fq == 0) {
#pragma unroll
            for (int ai = 0; ai < 2; ++ai)
#pragma unroll
                for (int m = 0; m < 4; ++m) { const int row = row0 + ai * HALF + m * 16, b = row / SEQ_, s = row % SEQ_; const float r = rs[ai][m];
#pragma unroll
                    for (int j = 0; j < 8; ++j) { const float a = (j < 4) ? acc[ai][0][m][0][j & 3] : acc[ai][0][m][1][j & 3]; const float z = a * r + bf[j];
                        const float ls = fminf(z, 0.f) - log1pf(expf(-fabsf(z)));
                        logf2[(size_t)(b * 8 + j) * SEQ_ + s] = ls * 1.4426950408889634f; } }
        }
    }
};
struct EpiRelu2 {
    static constexpr bool PERM = true, AFTER_DRAIN = false;
    bf16_t* H; const PG8_LAS float* rtab;
    __device__ __forceinline__ void operator()(const f32x4 (&acc)[2][2][4][2], const Unit& u, int wr, int wc, int fr, int fq, int ui) const {
        const int row0 = u.pm * BM + wr * 64 + fr, col0 = u.pn * BM + wc * 32 + 8 * fq;
#pragma unroll
        for (int ai = 0; ai < 2; ++ai)
#pragma unroll
            for (int m = 0; m < 4; ++m) { const int row = row0 + ai * HALF + m * 16; const float s = rtab[ui * 256 + wr * 64 + fr + ai * HALF + m * 16]; bf16_t* rowp = H + (size_t)row * 4096 + col0;
#pragma unroll
                for (int bj = 0; bj < 2; ++bj) { f32x4 v0 = acc[ai][bj][m][0] * s, v1 = acc[ai][bj][m][1] * s;
#pragma unroll
                    for (int e = 0; e < 4; ++e) { const float a = fmaxf(v0[e], 0.f), b = fmaxf(v1[e], 0.f); v0[e] = a * a; v1[e] = b * b; }
                    u32x4 w; w.x = cvt_pk_bf16(v0[0], v0[1]); w.y = cvt_pk_bf16(v0[2], v0[3]); w.z = cvt_pk_bf16(v1[0], v1[1]); w.w = cvt_pk_bf16(v1[2], v1[3]);
                    *(u32x4*)(rowp + bj * HALF) = w; } }
    }
};
struct EpiResid {
    static constexpr bool PERM = false, AFTER_DRAIN = false;
    bf16_t* xb; float* ssq; PG8_LAS float* P;
    __device__ __forceinline__ void operator()(const f32x4 (&acc)[2][2][4][2], const Unit& u, int wr, int wc, int fr, int fq, int) const {
        const int col0 = u.pn * BM + wc * 32 + 4 * fq;
#pragma unroll
        for (int ai = 0; ai < 2; ++ai)
#pragma unroll
            for (int m = 0; m < 4; ++m) { const int r = ai * HALF + wr * 64 + m * 16 + fr; const size_t off = (size_t)(u.pm * BM + r) * 1024 + col0; float s = 0.f;
#pragma unroll
                for (int bj = 0; bj < 2; ++bj)
#pragma unroll
                    for (int n = 0; n < 2; ++n) { const u32x2 bw = *(const u32x2*)(xb + off + bj * HALF + n * 16);
                        const f32x4 b = {__builtin_bit_cast(float, bw.x << 16), __builtin_bit_cast(float, bw.x & 0xffff0000u), __builtin_bit_cast(float, bw.y << 16), __builtin_bit_cast(float, bw.y & 0xffff0000u)};
                        const f32x4 v = b + acc[ai][bj][m][n];
                        u32x2 w; w.x = cvt_pk_bf16(v[0], v[1]); w.y = cvt_pk_bf16(v[2], v[3]); *(u32x2*)(xb + off + bj * HALF + n * 16) = w;
                        s += (v[0] * v[0] + v[1] * v[1]) + (v[2] * v[2] + v[3] * v[3]); }
                s += shx(s, 16, fr + 16 * fq); s += shx(s, 32, fr + 16 * fq);
                if (fq == 0) P[r * 4 + wc] = s;
                }
        asm volatile("s_waitcnt lgkmcnt(0)\n\ts_barrier" ::: "memory");
        int tid = threadIdx.x; asm volatile("" : "+v"(tid));
        if (tid < 256) { const f32x4 p = *(const PG8_LAS f32x4*)(P + tid * 4); ssq[(size_t)(u.pm * BM + tid) * 4 + u.pn] = (p[0] + p[1]) + (p[2] + p[3]); }
        asm volatile("s_waitcnt lgkmcnt(0)" ::: "memory");
    }
};
template <class Epi, class Sched, bool ALIGN_EPI = false, bool SP2 = false>
__device__ __forceinline__ void gemm_phase(PG8_LAS unsigned char* lds, const Gemm g, const Sched& S, const Epi& E) {
    int tid_ = threadIdx.x; asm volatile("" : "+v"(tid_));
    const int tid = tid_, wid = __builtin_amdgcn_readfirstlane(tid >> 6), lane = tid & 63, wr = wid >> 2, wc = wid & 3, fr = lane & 15, fq = lane >> 4;
    const int K = g.K, nt = K / BK;
    unsigned voffA[2], voffB[2];
#pragma unroll
    for (int i = 0; i < 2; ++i) { int R, C; stage_rc(tid * 16 + i * 8192, R, C); const int Rb = Epi::PERM ? ((R & ~31) + perm32(R & 31)) : R;
        voffA[i] = (unsigned)(R * K + C) * 2u; voffB[i] = (unsigned)(Rb * K + C) * 2u; }
    const size_t kstep = (size_t)(BK * 2);
    const size_t hstep = (size_t)HALF * K * 2;
    const size_t tstep = 2 * hstep;
    const unsigned ldsw = (unsigned)wid * 1024u;
    const int aoff = lds_byte(wr * 64 + fr, fq * 8), boff = lds_byte(wc * 32 + fr, fq * 8);
#define PG8_SA(b, h) (((b) * 2 + (h)) * HTB)
#define PG8_SB(b, h) ((4 + (b) * 2 + (h)) * HTB)
#define PG8_STAGE(bufoff, gbase, voff) do { _Pragma("unroll") for (int _i = 0; _i < 2; ++_i) \
        __builtin_amdgcn_global_load_lds((const unsigned*)((const char*)(gbase) + (voff)[_i]), (PG8_LAS unsigned*)(lds + (bufoff) + ldsw + _i * 8192), 16, 0, 0); } while (0)
#define PG8_LDA(dst, b, h) do { _Pragma("unroll") for (int m = 0; m < 4; ++m) _Pragma("unroll") for (int k = 0; k < 2; ++k) dst[m][k] = *(const PG8_LAS bf16x8*)(lds + PG8_SA(b, h) + aoff + m * 2048 + k * 1024); } while (0)
#define PG8_LDB(dst, b, h) do { _Pragma("unroll") for (int n = 0; n < 2; ++n) _Pragma("unroll") for (int k = 0; k < 2; ++k) dst[n][k] = *(const PG8_LAS bf16x8*)(lds + PG8_SB(b, h) + boff + n * 2048 + k * 1024); } while (0)
#define PG8_MMA(ai, bj, At, Bt) do { __builtin_amdgcn_s_setprio(1); _Pragma("unroll") for (int m = 0; m < 4; ++m) _Pragma("unroll") for (int n = 0; n < 2; ++n) _Pragma("unroll") for (int k = 0; k < 2; ++k) \
        acc[ai][bj][m][n] = __builtin_amdgcn_mfma_f32_16x16x32_bf16(Bt[n][k], At[m][k], acc[ai][bj][m][n], 0, 0, 0); __builtin_amdgcn_s_setprio(0); } while (0)
#define PG8_WAIT_V(n) asm volatile("s_waitcnt vmcnt(" #n ")" ::: "memory")
#define PG8_WAIT_L(n) asm volatile("s_waitcnt lgkmcnt(" #n ")" ::: "memory")
#define PG8_BAR __builtin_amdgcn_s_barrier()
#define PG8_SCHED __builtin_amdgcn_sched_barrier(0)
    Unit cur, nxt; int ui = 0;
    if (!S.next(0, cur)) return;
    f32x4 acc[2][2][4][2];
#pragma unroll
    for (int a = 0; a < 2; ++a)
#pragma unroll
        for (int b = 0; b < 2; ++b)
#pragma unroll
            for (int m = 0; m < 4; ++m)
#pragma unroll
                for (int n = 0; n < 2; ++n) acc[a][b][m][n] = (f32x4){0.f, 0.f, 0.f, 0.f};
    bf16x8 At[4][2], B0[2][2], B1[2][2];
    const char* cA = (const char*)g.A + (size_t)cur.pm * tstep; const char* cB = (const char*)g.Bt + (size_t)cur.pn * tstep;
    S.a_ready(cur);
    if constexpr (SP2) {
        PG8_STAGE(PG8_SB(0, 0), cB, voffB); PG8_STAGE(PG8_SB(0, 1), cB + hstep, voffB); PG8_STAGE(PG8_SA(0, 0), cA, voffA); PG8_STAGE(PG8_SA(0, 1), cA + hstep, voffA);
        if (wr == 1) PG8_BAR;
        PG8_WAIT_V(2); PG8_BAR;
        PG8_STAGE(PG8_SB(1, 0), cB + kstep, voffB); PG8_STAGE(PG8_SA(1, 0), cA + kstep, voffA); PG8_STAGE(PG8_SB(1, 1), cB + hstep + kstep, voffB);
        PG8_WAIT_V(6); PG8_BAR;
    } else {
        PG8_STAGE(PG8_SB(0, 0), cB, voffB); PG8_STAGE(PG8_SA(0, 0), cA, voffA); PG8_STAGE(PG8_SB(0, 1), cB + hstep, voffB); PG8_STAGE(PG8_SA(0, 1), cA + hstep, voffA);
        if (wr == 1) PG8_BAR;
        PG8_WAIT_V(4); PG8_BAR;
        PG8_STAGE(PG8_SB(1, 0), cB + kstep, voffB); PG8_STAGE(PG8_SA(1, 0), cA + kstep, voffA); PG8_STAGE(PG8_SB(1, 1), cB + hstep + kstep, voffB);
        PG8_WAIT_V(6); PG8_BAR;
    }
    for (;;) {
        const bool has_next = S.next(ui + 1, nxt);
        const char* nA = has_next ? (const char*)g.A + (size_t)nxt.pm * tstep : cA; const char* nB = has_next ? (const char*)g.Bt + (size_t)nxt.pn * tstep : cB;
        for (int t = 0; t < nt; t += 2) {
            const bool last = (t == nt - 2);
            const char* a1 = cA + (size_t)(t + 1) * kstep;
            const char* a2 = last ? nA : cA + (size_t)(t + 2) * kstep; const char* b2 = last ? nB : cB + (size_t)(t + 2) * kstep;
            const char* a3 = a2 + kstep; const char* b3 = b2 + kstep;
            if (last && has_next) S.a_ready(nxt);
            if constexpr (SP2) {
            PG8_LDB(B0, 0, 0); PG8_LDB(B1, 0, 1); PG8_SCHED; PG8_LDA(At, 0, 0); PG8_STAGE(PG8_SA(1, 1), a1 + hstep, voffA);
            PG8_WAIT_V(8); PG8_WAIT_L(0); PG8_BAR; PG8_MMA(0, 0, At, B0); PG8_MMA(0, 1, At, B1); PG8_BAR; PG8_SCHED;
            PG8_LDA(At, 0, 1); PG8_STAGE(PG8_SB(0, 0), b2, voffB); PG8_STAGE(PG8_SB(0, 1), b2 + hstep, voffB); PG8_STAGE(PG8_SA(0, 0), a2, voffA);
            PG8_WAIT_V(8); PG8_WAIT_L(0); PG8_BAR; PG8_MMA(1, 0, At, B0); PG8_MMA(1, 1, At, B1); PG8_BAR; PG8_SCHED;
            PG8_LDB(B0, 1, 0); PG8_LDB(B1, 1, 1); PG8_SCHED; PG8_LDA(At, 1, 0); PG8_STAGE(PG8_SA(0, 1), a2 + hstep, voffA);
            PG8_WAIT_V(8); PG8_WAIT_L(0); PG8_BAR; PG8_MMA(0, 0, At, B0); PG8_MMA(0, 1, At, B1); PG8_BAR; PG8_SCHED;
            PG8_LDA(At, 1, 1); PG8_STAGE(PG8_SB(1, 0), b3, voffB); PG8_STAGE(PG8_SB(1, 1), b3 + hstep, voffB); PG8_STAGE(PG8_SA(1, 0), a3, voffA);
            PG8_WAIT_V(8); PG8_WAIT_L(0); PG8_BAR; PG8_MMA(1, 0, At, B0); PG8_MMA(1, 1, At, B1); PG8_BAR; PG8_SCHED;
            } else {
            PG8_LDB(B0, 0, 0); PG8_SCHED; PG8_LDA(At, 0, 0); PG8_STAGE(PG8_SA(1, 1), a1 + hstep, voffA);
            PG8_WAIT_L(8); PG8_BAR; PG8_WAIT_L(0); PG8_MMA(0, 0, At, B0); PG8_BAR; PG8_SCHED;
            PG8_LDB(B1, 0, 1); PG8_STAGE(PG8_SB(0, 0), b2, voffB);
            PG8_BAR; PG8_WAIT_L(0); PG8_MMA(0, 1, At, B1); PG8_BAR;
            PG8_LDA(At, 0, 1); PG8_STAGE(PG8_SA(0, 0), a2, voffA);
            PG8_BAR; PG8_WAIT_L(0); PG8_MMA(1, 0, At, B0); PG8_BAR; PG8_SCHED;
            PG8_STAGE(PG8_SB(0, 1), b2 + hstep, voffB);
            PG8_WAIT_V(6); PG8_BAR; PG8_MMA(1, 1, At, B1); PG8_BAR;
            PG8_LDB(B0, 1, 0); PG8_SCHED; PG8_LDA(At, 1, 0); PG8_STAGE(PG8_SA(0, 1), a2 + hstep, voffA);
            PG8_WAIT_L(8); PG8_BAR; PG8_WAIT_L(0); PG8_MMA(0, 0, At, B0); PG8_BAR; PG8_SCHED;
            PG8_LDB(B1, 1, 1); PG8_STAGE(PG8_SB(1, 0), b3, voffB);
            PG8_BAR; PG8_WAIT_L(0); PG8_MMA(0, 1, At, B1); PG8_BAR;
            PG8_LDA(At, 1, 1); PG8_STAGE(PG8_SA(1, 0), a3, voffA);
            PG8_BAR; PG8_WAIT_L(0); PG8_MMA(1, 0, At, B0); PG8_BAR; PG8_SCHED;
            PG8_STAGE(PG8_SB(1, 1), b3 + hstep, voffB);
            PG8_WAIT_V(6); PG8_BAR; PG8_MMA(1, 1, At, B1); PG8_BAR;
            }
        }
        if constexpr (ALIGN_EPI) { if (wr == 0) PG8_BAR; }
        if constexpr (!Epi::AFTER_DRAIN) { E(acc, cur, wr, wc, fr, fq, ui); S.done(cur); }
        if (!has_next) break;
#pragma unroll
        for (int a = 0; a < 2; ++a)
#pragma unroll
            for (int b = 0; b < 2; ++b)
#pragma unroll
                for (int m = 0; m < 4; ++m)
#pragma unroll
                    for (int n = 0; n < 2; ++n) acc[a][b][m][n] = (f32x4){0.f, 0.f, 0.f, 0.f};
        cur = nxt; cA = nA; cB = nB; ++ui;
        if constexpr (ALIGN_EPI) { if (wr == 1) PG8_BAR; }
    }
    PG8_WAIT_V(0);
    if constexpr (!ALIGN_EPI) { if (wr == 0) PG8_BAR; }
    PG8_BAR;
    if constexpr (Epi::AFTER_DRAIN) { E.fused(acc, cur, wr, wc, fr, fq, lds, wid, lane); S.done(cur); }
#undef PG8_SA
#undef PG8_SB
#undef PG8_STAGE
#undef PG8_LDA
#undef PG8_LDB
#undef PG8_MMA
#undef PG8_WAIT_V
#undef PG8_WAIT_L
#undef PG8_BAR
#undef PG8_SCHED
}
}
#include <hip/hip_bf16.h>
#include <cmath>
namespace attn_body {
using bf16=__hip_bfloat16;
using bf16x8=__attribute__((ext_vector_type(8)))short;
using s16x4=__attribute__((ext_vector_type(4)))short;
using f32x16=__attribute__((ext_vector_type(16)))float;
using u32x4=__attribute__((ext_vector_type(4)))unsigned;
constexpr int BATCH=2,SEQ=16384,D=64,ZP=3072,OP=1024;
constexpr int NW=8,QBLK=32,QB=QBLK*NW,KVBLK=64,NQB=SEQ/QB;
constexpr int ATTN_UNIT_ROWS=QB;
__device__ __forceinline__ int crow(int r,int hi){return (r&3)+8*(r>>2)+4*hi;}
#define SBAR() __builtin_amdgcn_sched_barrier(0)
__device__ __forceinline__ void cmask(f32x16&p0,f32x16&p1,int jb,int qrel,int hi){
  const float NEG=-INFINITY; int kb=64*jb+4*hi;
  #pragma unroll
  for(int r=0;r<16;++r){int kv=kb+(r&3)+8*(r>>2); if(kv>qrel)p0[r]=NEG; if(kv+32>qrel)p1[r]=NEG;}
}

constexpr int NSLOT=3, SLOTB=8192;
constexpr int LDS_K=0, LDS_V=NSLOT*SLOTB, LDS_WS=2*NSLOT*SLOTB, LDS_OST=LDS_WS+NW*64*4, LDS_BYTES=LDS_OST+NW*4096;
constexpr int LDS_EXTRA=LDS_BYTES, LDS_CS=LDS_EXTRA  , LDS_OST2=LDS_EXTRA  , LDS_TBL=LDS_EXTRA+NW*4096  , LDS_AUX=LDS_EXTRA+65536, LDS_TOTAL=LDS_AUX+256;
typedef __attribute__((address_space(3))) float ldsf; typedef __attribute__((address_space(3))) const float cldsf; typedef float f32x4a __attribute__((ext_vector_type(4)));
constexpr float LOG2E=1.4426950408889634f;
constexpr float C2=0.125f*1.4426950408889634f;
__device__ __forceinline__ void glds16(const void*gsrc,unsigned lds_dst){unsigned keep;
  asm volatile("s_mov_b32 %0, m0\n\ts_mov_b32 m0, %2\n\ts_nop 0\n\tglobal_load_lds_dwordx4 %1, off\n\ts_mov_b32 m0, %0":"=&s"(keep):"v"(gsrc),"s"(lds_dst):"memory");}
__device__ __forceinline__ void glds16s(const void*sbase,unsigned voff,unsigned lds_dst){unsigned keep;
  asm volatile("s_mov_b32 %0, m0\n\ts_mov_b32 m0, %3\n\ts_nop 0\n\tglobal_load_lds_dwordx4 %1, %2\n\ts_mov_b32 m0, %0":"=&s"(keep):"v"(voff),"s"(sbase),"s"(lds_dst):"memory");}
__device__ __forceinline__ void glds16s3(const void*kbase,unsigned koff,unsigned kdst,const void*vbase,unsigned voff,unsigned vdst){unsigned keep;
  asm volatile("s_mov_b32 %0, m0\n\ts_mov_b32 m0, %3\n\ts_nop 0\n\tglobal_load_lds_dwordx4 %1, %2\n\t"
               "s_mov_b32 m0, %6\n\ts_nop 0\n\tglobal_load_lds_dwordx4 %4, %5\n\t"
               "s_mov_b32 m0, %7\n\ts_nop 0\n\tglobal_load_lds_dwordx4 %4, %5 offset:128\n\ts_mov_b32 m0, %0"
               :"=&s"(keep):"v"(koff),"s"(kbase),"s"(kdst),"v"(voff),"s"(vbase),"s"(vdst),"s"(vdst+8192u-128u):"memory");}
__device__ __forceinline__ float max3f(float a,float b,float c){float r;asm("v_max3_f32 %0, %1, %2, %3":"=v"(r):"v"(a),"v"(b),"v"(c));return r;}
__device__ __forceinline__ float max2f(float a,float b){float r;asm("v_max_f32_e32 %0, %1, %2":"=v"(r):"v"(a),"v"(b));return r;}
__device__ __forceinline__ float fadd_s(float a,float b){float r;asm("v_add_f32_e32 %0, %1, %2":"=v"(r):"v"(a),"v"(b));return r;}
__device__ __forceinline__ float fsub_s(float a,float b){float r;asm("v_sub_f32_e32 %0, %1, %2":"=v"(r):"v"(a),"v"(b));return r;}
typedef float f32x2_t __attribute__((ext_vector_type(2))); typedef __bf16 bf16x2_t __attribute__((ext_vector_type(2)));
__device__ __forceinline__ unsigned cvtpk_s(float lo,float hi){f32x2_t v={lo,hi};bf16x2_t b=__builtin_convertvector(v,bf16x2_t);return __builtin_bit_cast(unsigned,b);}
#define WAIT_BAR(N) asm volatile("s_waitcnt vmcnt(" #N ") lgkmcnt(0)\n\ts_barrier":::"memory")

__device__ __forceinline__ void qkt(f32x16&p0,f32x16&p1,const char*Kslot,const bf16x8*qr,const f32x16&negm,int r32,int hi){
  const char*kb=Kslot+hi*1024+r32*16;
  #pragma unroll
  for(int d0=0;d0<4;++d0){
    const bf16x8 b0=*reinterpret_cast<const bf16x8*>(kb+d0*2048);
    const bf16x8 b1=*reinterpret_cast<const bf16x8*>(kb+d0*2048+512);
    if(d0==0){p0=__builtin_amdgcn_mfma_f32_32x32x16_bf16(b0,qr[0],negm,0,0,0);p1=__builtin_amdgcn_mfma_f32_32x32x16_bf16(b1,qr[0],negm,0,0,0);}
    else{p0=__builtin_amdgcn_mfma_f32_32x32x16_bf16(b0,qr[d0],p0,0,0,0);p1=__builtin_amdgcn_mfma_f32_32x32x16_bf16(b1,qr[d0],p1,0,0,0);}}
}
typedef __attribute__((address_space(3))) const char* lds_cptr;
typedef short v4i16_t __attribute__((ext_vector_type(4)));
__device__ __forceinline__ void kload8(bf16x8*kf,lds_cptr kp){
  kf[0]=*(const __attribute__((address_space(3))) bf16x8*)(kp);      kf[1]=*(const __attribute__((address_space(3))) bf16x8*)(kp+512);
  kf[2]=*(const __attribute__((address_space(3))) bf16x8*)(kp+2048); kf[3]=*(const __attribute__((address_space(3))) bf16x8*)(kp+2560);
  kf[4]=*(const __attribute__((address_space(3))) bf16x8*)(kp+4096); kf[5]=*(const __attribute__((address_space(3))) bf16x8*)(kp+4608);
  kf[6]=*(const __attribute__((address_space(3))) bf16x8*)(kp+6144); kf[7]=*(const __attribute__((address_space(3))) bf16x8*)(kp+6656);
}
__device__ __forceinline__ void kload2(bf16x8*kf,lds_cptr kp,int j){ kf[2*j]=*(const __attribute__((address_space(3))) bf16x8*)(kp+j*2048); kf[2*j+1]=*(const __attribute__((address_space(3))) bf16x8*)(kp+j*2048+512); }
__device__ __forceinline__ s16x4 vtr(lds_cptr p){ return __builtin_bit_cast(s16x4,__builtin_amdgcn_ds_read_tr16_b64_v4i16((__attribute__((address_space(3))) v4i16_t*)p)); }
__device__ __forceinline__ float rowmax(const f32x16&p0,const f32x16&p1){
  float a=max3f(p0[0],p0[1],p1[0]),b=max3f(p0[2],p0[3],p1[1]);a=max3f(a,p1[2],p1[3]);
  #pragma unroll
  for(int r=4;r<16;r+=4){a=max3f(a,p0[r],p0[r+1]);b=max3f(b,p0[r+2],p0[r+3]);a=max3f(a,p1[r],p1[r+1]);b=max3f(b,p1[r+2],p1[r+3]);}
  const float m=max2f(a,b);
  auto rr=__builtin_amdgcn_permlane32_swap(__float_as_uint(m),__float_as_uint(m),false,false);
  return max2f(__uint_as_float(rr[0]),__uint_as_float(rr[1]));
}
__device__ __forceinline__ void pv(f32x16*o,int vb,bf16x8 pa0,bf16x8 pa1,bf16x8 pa2,bf16x8 pa3){
  #pragma unroll
  for(int d0=0;d0<2;++d0){s16x4 lo[4],hi[4];
    #pragma unroll
    for(int ks=0;ks<4;++ks){
      asm volatile("ds_read_b64_tr_b16 %0,%1 offset:%c2":"=&v"(lo[ks]):"v"(vb),"i"(d0*4096+ks*1024):"memory");
      asm volatile("ds_read_b64_tr_b16 %0,%1 offset:%c2":"=&v"(hi[ks]):"v"(vb),"i"(d0*4096+ks*1024+512):"memory");}
    asm volatile("s_waitcnt lgkmcnt(0)":::"memory");SBAR();
    #define PK(k) (bf16x8){lo[k][0],lo[k][1],lo[k][2],lo[k][3],hi[k][0],hi[k][1],hi[k][2],hi[k][3]}
    o[d0]=__builtin_amdgcn_mfma_f32_32x32x16_bf16(pa0,PK(0),o[d0],0,0,0);
    o[d0]=__builtin_amdgcn_mfma_f32_32x32x16_bf16(pa1,PK(1),o[d0],0,0,0);
    o[d0]=__builtin_amdgcn_mfma_f32_32x32x16_bf16(pa2,PK(2),o[d0],0,0,0);
    o[d0]=__builtin_amdgcn_mfma_f32_32x32x16_bf16(pa3,PK(3),o[d0],0,0,0);
    #undef PK
  }
}


__device__ __forceinline__ void subcs(f32x16&p0,f32x16&p1,cldsf*c,float mh){
  #pragma unroll
  for(int g=0;g<4;++g){ const f32x4a a=*(const __attribute__((address_space(3))) f32x4a*)(c+8*g)+mh, b4=*(const __attribute__((address_space(3))) f32x4a*)(c+32+8*g)+mh;
    #pragma unroll
    for(int i=0;i<4;++i){p0[4*g+i]-=a[i];p1[4*g+i]-=b4[i];}
    if(g==1)SBAR(); }
}
__device__ __forceinline__ void submh(f32x16&p0,f32x16&p1,float mh){
  #pragma unroll
  for(int r=0;r<16;++r){p0[r]-=mh;p1[r]-=mh;}
}
__device__ __forceinline__ void dbias(f32x16&p0,f32x16&p1,int jb,int wid,int r32,int hi,cldsf*tbl){
  if(jb>(wid>>1)){
    #pragma unroll
    for(int r=0;r<16;++r){p0[r]=-INFINITY;p1[r]=-INFINITY;}
  } else {
    cldsf*tp=tbl+(447+64*jb-(32*wid+r32)+4*hi);
    #pragma unroll
    for(int g=0;g<4;++g){
      #pragma unroll
      for(int i=0;i<4;++i){p0[4*g+i]+=tp[8*g+i];p1[4*g+i]+=tp[32+8*g+i];}}
  }
}
#ifndef ATTN_STORE16
#define ATTN_STORE16(p,v) (*(u32x4*)(p)=(v))
#endif
template<int MODE,int THRL,bool NOMAX> __device__ __forceinline__ void attn_unit(int qb,int kt0,const bf16*Qh,const bf16*__restrict__ Kh0,const bf16*__restrict__ Vh0,bf16*Oh,char*shm,int EPI,int stgoff,float lam){
  const bf16*Kh=Kh0+(long)kt0*KVBLK*ZP,*Vh=Vh0+(long)kt0*KVBLK*ZP;
  int tid_=threadIdx.x; asm volatile("":"+v"(tid_)); const int tid=tid_,lane=tid&63,r32=lane&31,hi=lane>>5; const int wid=__builtin_amdgcn_readfirstlane(tid>>6);
  const int q0=qb*QB;
  const bf16*Qw=Qh+(long)(q0+wid*QBLK)*ZP;
  cldsf*csl=(cldsf*)(lds_cptr)shm+LDS_CS/4+64*kt0; cldsf*tbl=(cldsf*)(lds_cptr)shm+LDS_TBL/4; (void)csl;(void)tbl;
  const unsigned lds0=(unsigned)(uintptr_t)shm;
  float*wsf=(float*)(shm+LDS_WS)+wid*64;
  const unsigned koff=(unsigned)(lane*ZP+wid*8)*2u;
  const unsigned voff=(unsigned)((16*(wid&3)+(lane>>2))*ZP+(wid>>2)*32+(lane&3)*8)*2u;
  const unsigned kdst=lds0+LDS_K+wid*1024, vdst=lds0+LDS_V+wid*1024;
  #define DMA_K(t,slot) glds16s(Kh+(long)(t)*KVBLK*ZP,koff,(unsigned)__builtin_amdgcn_readfirstlane(kdst+(slot)))
  #define DMA_V(t,slot) glds16s(Vh+(long)(t)*KVBLK*ZP,voff,(unsigned)__builtin_amdgcn_readfirstlane(vdst+(slot)))
  const int vb0=(int)(lds0+LDS_V)+((lane>>4)&1)*32+(lane&3)*8+(4*hi+((lane&15)>>2))*64;
  const char*Kbase=shm+LDS_K; bf16x8 kf[8];
  const lds_cptr shm3=(lds_cptr)shm; const lds_cptr kp0=shm3+LDS_K+hi*1024+r32*16; const lds_cptr vp0=shm3+LDS_V+((lane>>4)&1)*32+(lane&3)*8+(4*hi+((lane&15)>>2))*64;
  const int NT=(q0+QB)/KVBLK-kt0;
  DMA_K(0,0);DMA_V(0,0);DMA_K(1,SLOTB);
  bf16x8 qr[4];
  #pragma unroll
  for(int d0=0;d0<4;++d0)qr[d0]=*reinterpret_cast<const bf16x8*>(&Qw[(long)r32*ZP+d0*16+hi*8]);
  float mhat=0.f,l_reg=0.f;f32x16 o[2];o[0]=f32x16{};o[1]=f32x16{};f32x16 negm=f32x16{}; if(MODE==1){asm volatile("":"+v"(negm));}
  if(NOMAX){ mhat=-((cldsf*)(lds_cptr)shm+LDS_CS/4)[q0+wid*QBLK+r32]; }
  const int qrel=wid*QBLK+r32;
  #define CMASK(P0,P1,t) do{ const int jb_=(t)-(NT-4); if(MODE==0){ subcs(P0,P1,csl+64*(t)+4*hi,mhat); if(jb_>=0)cmask(P0,P1,jb_,qrel,hi); } else { if(jb_>=-3)dbias(P0,P1,jb_,wid,r32,hi,tbl); } }while(0)
  bool resc=false;
  #define START(P0,P1) do{ resc=false; if(!NOMAX) \
    { const float rm=rowmax(P0,P1); const float dl=rm; mhat=fadd_s(mhat,dl); \
      _Pragma("unroll") for(int r=0;r<16;++r){P0[r]=fsub_s(P0[r],dl);P1[r]=fsub_s(P1[r],dl);} \
      if(MODE==1){ _Pragma("unroll") for(int r=0;r<16;++r)negm[r]=-mhat; asm volatile("":"+v"(negm)); } } \
    _Pragma("unroll") for(int r=0;r<16;++r)P0[r]=__builtin_amdgcn_exp2f(P0[r]); }while(0)
  #define RESC() do{ if(resc){ asm volatile("s_waitcnt lgkmcnt(0)":::"memory"); \
      _Pragma("unroll") for(int d_=0;d_<2;++d_) _Pragma("unroll") for(int r=0;r<16;++r)o[d_][r]*=wsf[crow(r,hi)]; } }while(0)
  f32x16 pA0,pA1,pB0,pB1;
  int sl_prev=0,sl_cur=0,sl_next=SLOTB;
  #define ROT() do{sl_prev=sl_cur;sl_cur=sl_next;sl_next=(sl_next==(NSLOT-1)*SLOTB)?0:sl_next+SLOTB;}while(0)
  DMA_K(2,2*SLOTB);
  WAIT_BAR(3);
  qkt(pA0,pA1,Kbase,qr,negm,r32,hi);asm volatile("s_nop 15\n\ts_nop 7":"+v"(pA0),"+v"(pA1));CMASK(pA0,pA1,0);
  START(pA0,pA1);
  _Pragma("unroll") for(int r=0;r<16;++r)pA1[r]=__builtin_amdgcn_exp2f(pA1[r]);
  WAIT_BAR(0);
  DMA_K(3,0);DMA_V(1,SLOTB);
  ROT();
  kload8(kf,kp0+sl_cur);
  WAIT_BAR(2);
  s16x4 vlo[8],vhi[8]; u32x4 pw0,pw1,pw2,pw3;
  #define PKW(P,B) cvtpk_s(P[B],P[B+1])
  #define PAF(k) __builtin_bit_cast(bf16x8,pw##k)
  #define VFR(i) (bf16x8){vlo[i][0],vlo[i][1],vlo[i][2],vlo[i][3],vhi[i][0],vhi[i][1],vhi[i][2],vhi[i][3]}
  #define PIN(x) asm volatile("":"+v"(x))
  #define MX3(a,b,c) __builtin_fmaxf(__builtin_fmaxf((a),(b)),(c))
  #define GAPA(MF,A0,A1,A2,A3,W0,W1,PW) do{ MF; sacc+=A0; sacc+=A1; sacc+=A2; sacc+=A3; PIN(sacc); W0; W1; PIN(PW); SBAR(); }while(0)
  #define EX(v) __builtin_amdgcn_exp2f(v)
  #define GAPB(MF,X,B) do{ MF; X[B]=EX(X[B]); X[B+1]=EX(X[B+1]); X[B+2]=EX(X[B+2]); X[B+3]=EX(X[B+3]); PIN(X); SBAR(); }while(0)
  #define VRD(i) do{ vlo[i]=vtr(vp_+(((i)>>2)*4096+((i)&3)*1024)); vhi[i]=vtr(vp_+(((i)>>2)*4096+((i)&3)*1024+512)); }while(0)
  #define KRD(G,j) do{ if(G){ kload2(kf,kp0+sl_next,j); SBAR(); } }while(0)
  #define STEP(C0,C1,P0,P1,t,GK,GV,GL) do{ SBAR(); \
    const lds_cptr vp_=vp0+sl_prev; \
    VRD(0); SBAR(); float sacc=(P0[0]+P0[1]); \
    GAPA(C0=__builtin_amdgcn_mfma_f32_32x32x16_bf16(kf[0],qr[0],negm,0,0,0), P0[2],P0[3],P0[4],P0[5],     pw0[0]=PKW(P0,0), pw0[1]=PKW(P0,2), pw0); \
    VRD(4); SBAR(); GAPA(C1=__builtin_amdgcn_mfma_f32_32x32x16_bf16(kf[1],qr[0],negm,0,0,0), P0[6],P0[7],P0[8],P0[9],     pw0[2]=PKW(P0,4), pw0[3]=PKW(P0,6), pw0); \
    VRD(1); SBAR(); GAPA(C0=__builtin_amdgcn_mfma_f32_32x32x16_bf16(kf[2],qr[1],C0,0,0,0),   P0[10],P0[11],P0[12],P0[13], pw1[0]=PKW(P0,8), pw1[1]=PKW(P0,10), pw1); \
    VRD(5); SBAR(); GAPA(C1=__builtin_amdgcn_mfma_f32_32x32x16_bf16(kf[3],qr[1],C1,0,0,0),   P0[14],P0[15],P1[0],P1[1],   pw1[2]=PKW(P0,12),pw1[3]=PKW(P0,14), pw1); \
    VRD(2); SBAR(); GAPA(C0=__builtin_amdgcn_mfma_f32_32x32x16_bf16(kf[4],qr[2],C0,0,0,0),   P1[2],P1[3],P1[4],P1[5],     pw2[0]=PKW(P1,0), pw2[1]=PKW(P1,2), pw2); \
    VRD(6); SBAR(); GAPA(C1=__builtin_amdgcn_mfma_f32_32x32x16_bf16(kf[5],qr[2],C1,0,0,0),   P1[6],P1[7],P1[8],P1[9],     pw2[2]=PKW(P1,4), pw2[3]=PKW(P1,6), pw2); \
    VRD(3); SBAR(); GAPA(C0=__builtin_amdgcn_mfma_f32_32x32x16_bf16(kf[6],qr[3],C0,0,0,0),   P1[10],P1[11],P1[12],P1[13], pw3[0]=PKW(P1,8), pw3[1]=PKW(P1,10), pw3); \
    VRD(7); SBAR(); GAPA(C1=__builtin_amdgcn_mfma_f32_32x32x16_bf16(kf[7],qr[3],C1,0,0,0),   P1[14],P1[15],0.f,0.f,       pw3[2]=PKW(P1,12),pw3[3]=PKW(P1,14), pw3); \
    l_reg+=sacc; \
    if(GK){DMA_K((t)+3,sl_cur);} if(GV){DMA_V((t)+1,sl_next);} \
    CMASK(C0,C1,t); \
    if(!NOMAX){ float a=MX3(C0[0],C0[1],C1[0]),b=MX3(C0[2],C0[3],C1[1]); a=MX3(a,C1[2],C1[3]); \
      _Pragma("unroll") for(int r=4;r<16;r+=4){a=MX3(a,C0[r],C0[r+1]);b=MX3(b,C0[r+2],C0[r+3]);a=MX3(a,C1[r],C1[r+1]);b=MX3(b,C1[r+2],C1[r+3]);} \
      float rm=__builtin_fmaxf(a,b); { auto rr=__builtin_amdgcn_permlane32_swap(__float_as_uint(rm),__float_as_uint(rm),false,false); rm=__builtin_fmaxf(__uint_as_float(rr[0]),__uint_as_float(rr[1])); } \
      resc=false; \
      if(__builtin_expect(__any(rm>(float)THRL),0)){ const float dl=__builtin_fmaxf(rm,0.f); mhat+=dl; \
        _Pragma("unroll") for(int r=0;r<16;++r){C0[r]-=dl;C1[r]-=dl;} \
        if(MODE==1){ _Pragma("unroll") for(int r=0;r<16;++r)negm[r]=-mhat; asm volatile("":"+v"(negm)); } \
        const float f=__builtin_amdgcn_exp2f(-dl); l_reg*=f; if(hi==0)wsf[r32]=f; resc=true; } } \
    SBAR(); \
    GAPB(o[0]=__builtin_amdgcn_mfma_f32_32x32x16_bf16(PAF(0),VFR(0),o[0],0,0,0), C0,0); \
    GAPB(o[1]=__builtin_amdgcn_mfma_f32_32x32x16_bf16(PAF(0),VFR(4),o[1],0,0,0), C0,4); \
    KRD(GL,0); GAPB(o[0]=__builtin_amdgcn_mfma_f32_32x32x16_bf16(PAF(1),VFR(1),o[0],0,0,0), C0,8); \
    KRD(GL,1); GAPB(o[1]=__builtin_amdgcn_mfma_f32_32x32x16_bf16(PAF(1),VFR(5),o[1],0,0,0), C0,12); \
    KRD(GL,2); GAPB(o[0]=__builtin_amdgcn_mfma_f32_32x32x16_bf16(PAF(2),VFR(2),o[0],0,0,0), C1,0); \
    KRD(GL,3); GAPB(o[1]=__builtin_amdgcn_mfma_f32_32x32x16_bf16(PAF(2),VFR(6),o[1],0,0,0), C1,4); \
    GAPB(o[0]=__builtin_amdgcn_mfma_f32_32x32x16_bf16(PAF(3),VFR(3),o[0],0,0,0), C1,8); \
    GAPB(o[1]=__builtin_amdgcn_mfma_f32_32x32x16_bf16(PAF(3),VFR(7),o[1],0,0,0), C1,12); \
    }while(0)
  int t=1;
  #undef CMASK
  #define CMASK(P0,P1,t) do{ if(MODE==0){ subcs(P0,P1,csl+64*(t)+4*hi,mhat); } }while(0)
  for(;t+7<NT;t+=2){
    STEP(pB0,pB1,pA0,pA1,t,true,true,true);     WAIT_BAR(2); RESC(); ROT();
    STEP(pA0,pA1,pB0,pB1,t+1,true,true,true);   WAIT_BAR(2); RESC(); ROT();
  }
  #undef CMASK
  #define CMASK(P0,P1,t) do{ const int jb_=(t)-(NT-4); if(MODE==0){ subcs(P0,P1,csl+64*(t)+4*hi,mhat); if(jb_>=0)cmask(P0,P1,jb_,qrel,hi); } else { if(jb_>=-3)dbias(P0,P1,jb_,wid,r32,hi,tbl); } }while(0)
  #define ENDW(tt) do{ if((tt)+3<NT){WAIT_BAR(2);} else if((tt)+2<NT){WAIT_BAR(1);} else {WAIT_BAR(0);} }while(0)
  for(;t+1<NT;t+=2){
    STEP(pB0,pB1,pA0,pA1,t,(t+3<NT),(t+1<NT),(t+1<NT));       ENDW(t);   RESC(); ROT();
    STEP(pA0,pA1,pB0,pB1,t+1,(t+4<NT),(t+2<NT),(t+2<NT));     ENDW(t+1); RESC(); ROT();
  }
  STEP(pB0,pB1,pA0,pA1,NT-1,false,false,false); RESC();
  { float sacc=pB0[0]+pB0[1]; _Pragma("unroll") for(int r=2;r<16;++r)sacc+=pB0[r]; _Pragma("unroll") for(int r=0;r<16;++r)sacc+=pB1[r]; l_reg+=sacc;
    pw0=(u32x4){PKW(pB0,0),PKW(pB0,2),PKW(pB0,4),PKW(pB0,6)};pw1=(u32x4){PKW(pB0,8),PKW(pB0,10),PKW(pB0,12),PKW(pB0,14)};pw2=(u32x4){PKW(pB1,0),PKW(pB1,2),PKW(pB1,4),PKW(pB1,6)};pw3=(u32x4){PKW(pB1,8),PKW(pB1,10),PKW(pB1,12),PKW(pB1,14)};
    SBAR(); pv(o,vb0+sl_cur,PAF(0),PAF(1),PAF(2),PAF(3)); }
  #undef PKW
  #undef PAF
  #undef VFR
  #undef PIN
  #undef MX3
  #undef GAPA
  #undef GAPB
  #undef EX
  #undef VRD
  #undef KRD
  #undef STEP
  #undef ENDW
  {auto rr=__builtin_amdgcn_permlane32_swap(__float_as_uint(l_reg),__float_as_uint(l_reg),false,false);l_reg=__uint_as_float(rr[0])+__uint_as_float(rr[1]);}
  if(hi==0)wsf[32+r32]=l_reg;asm volatile("s_waitcnt lgkmcnt(0)":::"memory");
  float rli[16];
  #pragma unroll
  for(int r=0;r<16;++r)rli[r]=__builtin_amdgcn_rcpf(wsf[32+crow(r,hi)]);
  { bf16*stg=(bf16*)(shm+stgoff)+wid*2048;
    #pragma unroll
    for(int r=0;r<16;++r){const int orow=crow(r,hi);
      #pragma unroll
      for(int d0=0;d0<2;++d0){ float val=o[d0][r]*rli[r];
        if(EPI==2){ val=__bfloat162float(stg[orow*64+d0*32+r32])-lam*val; }
        stg[orow*64+d0*32+r32]=__float2bfloat16(val);}}
    asm volatile("s_waitcnt lgkmcnt(0)":::"memory");
    if(EPI==0){ bf16*Ow=Oh+(long)(q0+wid*QBLK)*OP;
      #pragma unroll
      for(int i=0;i<4;++i){const int row=i*8+(lane>>3),ch=lane&7; const u32x4 v=*(const u32x4*)(stg+row*64+ch*8); ATTN_STORE16(Ow+(long)row*OP+ch*8,v);} } }
  asm volatile("s_waitcnt lgkmcnt(0)\n\ts_barrier":::"memory");
  #undef DMA_K
  #undef DMA_V
  #undef CMASK
  #undef START
  #undef RESC
  #undef ROT
}
constexpr int D2_K=0, D2_V=NSLOT*SLOTB, D2_WS=D2_V+NSLOT*2*SLOTB, D2_OST=D2_WS+NW*64*4, D2_TBL=D2_OST+NW*8192, D2_END=D2_TBL+2048;
static_assert(D2_END<=LDS_AUX,"diff unit LDS map");
template<int THRL,bool NOMAX> __device__ __forceinline__ void attn_unit2(int qb,const bf16*Qh,const bf16*__restrict__ Kh,const bf16*__restrict__ Vh,char*shm,int EPI,float lam){
  constexpr int MODE=1;
  int tid_=threadIdx.x; asm volatile("":"+v"(tid_)); const int tid=tid_,lane=tid&63,r32=lane&31,hi=lane>>5; const int wid=__builtin_amdgcn_readfirstlane(tid>>6);
  const int q0=qb*QB;
  const bf16*Qw=Qh+(long)(q0+wid*QBLK)*ZP;
  cldsf*csl=nullptr; cldsf*tbl=(cldsf*)(lds_cptr)shm+D2_TBL/4; (void)csl;(void)tbl;
  const unsigned lds0=(unsigned)(uintptr_t)shm;
  float*wsf=(float*)(shm+D2_WS)+wid*64;
  const unsigned koff=(unsigned)(lane*ZP+wid*8)*2u;
  const unsigned voff=(unsigned)((16*(wid&3)+(lane>>2))*ZP+(wid>>2)*32+(lane&3)*8)*2u;
  const unsigned kdst=lds0+D2_K+wid*1024, vdst=lds0+D2_V+wid*1024;
  #define DMA_K(t,slot) glds16s(Kh+(long)(t)*KVBLK*ZP,koff,(unsigned)__builtin_amdgcn_readfirstlane(kdst+(slot)))
  #define DMA_V(t,slot) do{ glds16s(Vh+(long)(t)*KVBLK*ZP,voff,(unsigned)__builtin_amdgcn_readfirstlane(vdst+2*(slot))); glds16s(Vh+(long)(t)*KVBLK*ZP+64,voff,(unsigned)__builtin_amdgcn_readfirstlane(vdst+2*(slot)+8192)); }while(0)
  const int vb0=(int)(lds0+D2_V)+((lane>>4)&1)*32+(lane&3)*8+(4*hi+((lane&15)>>2))*64;
  const char*Kbase=shm+D2_K; bf16x8 kf[8];
  const lds_cptr shm3=(lds_cptr)shm; const lds_cptr kp0=shm3+D2_K+hi*1024+r32*16; const lds_cptr vp0=shm3+D2_V+((lane>>4)&1)*32+(lane&3)*8+(4*hi+((lane&15)>>2))*64;
  const int NT=(q0+QB)/KVBLK;
  DMA_K(0,0);DMA_V(0,0);DMA_K(1,SLOTB);
  bf16x8 qr[4];
  #pragma unroll
  for(int d0=0;d0<4;++d0)qr[d0]=*reinterpret_cast<const bf16x8*>(&Qw[(long)r32*ZP+d0*16+hi*8]);
  float mhat=0.f,l_reg=0.f;f32x16 o[4];o[0]=f32x16{};o[1]=f32x16{};o[2]=f32x16{};o[3]=f32x16{};
  const f32x16 zc=f32x16{};
  #define FIX(C0,C1,t) do{ const int jb_=(t)-(NT-4); submh(C0,C1,mhat); if(jb_>=-3)dbias(C0,C1,jb_,wid,r32,hi,tbl); }while(0)
  bool resc=false;
  #define RESC() do{ if(resc){ asm volatile("s_waitcnt lgkmcnt(0)":::"memory"); \
      _Pragma("unroll") for(int d_=0;d_<4;++d_) _Pragma("unroll") for(int r=0;r<16;++r)o[d_][r]*=wsf[crow(r,hi)]; } }while(0)
  f32x16 c0,c1;
  u32x4 pa0,pa1,pa2,pa3,pb0,pb1,pb2,pb3;
  int sl_prev=0,sl_cur=0,sl_next=SLOTB;
  #define ROT() do{sl_prev=sl_cur;sl_cur=sl_next;sl_next=(sl_next==(NSLOT-1)*SLOTB)?0:sl_next+SLOTB;}while(0)
  DMA_K(2,2*SLOTB);
  WAIT_BAR(3);
  #define EX(v) __builtin_amdgcn_exp2f(v)
  #define PKW(P,B) cvtpk_s(P[B],P[B+1])
  #define PIN(x) asm volatile("":"+v"(x))
  qkt(c0,c1,Kbase,qr,zc,r32,hi);asm volatile("s_nop 15\n\ts_nop 7":"+v"(c0),"+v"(c1));
  { const int jb_=0-(NT-4); if(jb_>=-3)dbias(c0,c1,jb_,wid,r32,hi,tbl); }
  { const float rm=NOMAX?0.f:rowmax(c0,c1); mhat=rm;
    _Pragma("unroll") for(int r=0;r<16;++r){c0[r]=EX(c0[r]-rm);c1[r]=EX(c1[r]-rm);}
    float sacc=0.f; _Pragma("unroll") for(int r=0;r<16;++r){sacc+=c0[r];} _Pragma("unroll") for(int r=0;r<16;++r){sacc+=c1[r];} l_reg=sacc;
    pa0=(u32x4){PKW(c0,0),PKW(c0,2),PKW(c0,4),PKW(c0,6)};pa1=(u32x4){PKW(c0,8),PKW(c0,10),PKW(c0,12),PKW(c0,14)};pa2=(u32x4){PKW(c1,0),PKW(c1,2),PKW(c1,4),PKW(c1,6)};pa3=(u32x4){PKW(c1,8),PKW(c1,10),PKW(c1,12),PKW(c1,14)}; }
  WAIT_BAR(0);
  DMA_K(3,0);DMA_V(1,SLOTB);
  ROT();
  kload8(kf,kp0+sl_cur);
  WAIT_BAR(3);
  s16x4 vlo[8],vhi[8];
  #define PAF(S,k) __builtin_bit_cast(bf16x8,S##k)
  #define VFR(i) (bf16x8){vlo[i][0],vlo[i][1],vlo[i][2],vlo[i][3],vhi[i][0],vhi[i][1],vhi[i][2],vhi[i][3]}
  #define MX3(a,b,c) __builtin_fmaxf(__builtin_fmaxf((a),(b)),(c))
  #define VRD(i) do{ vlo[i]=vtr(vp_+(((i)>>2)*4096+((i)&3)*1024)); vhi[i]=vtr(vp_+(((i)>>2)*4096+((i)&3)*1024+512)); }while(0)
  #define VRDB(i) do{ vlo[i]=vtr(vp_+(8192+((i)>>2)*4096+((i)&3)*1024)); vhi[i]=vtr(vp_+(8192+((i)>>2)*4096+((i)&3)*1024+512)); SBAR(); }while(0)
  #define KRD(G,j) do{ if(G){ kload2(kf,kp0+sl_next,j); SBAR(); } }while(0)
  #define GAPA(MF) do{ MF; SBAR(); }while(0)
  #define GAPB(MF,X,B,DV,DI) do{ MF; X[B]=EX(X[B]); X[B+1]=EX(X[B+1]); sacc+=X[B]; sacc+=X[B+1]; DV[DI]=cvtpk_s(X[B],X[B+1]); PIN(sacc); PIN(DV); SBAR(); }while(0)
  #define GAPB4(MF,X,B,DV,DI) do{ MF; X[B]=EX(X[B]); X[B+1]=EX(X[B+1]); X[B+2]=EX(X[B+2]); X[B+3]=EX(X[B+3]); sacc+=X[B]; sacc+=X[B+1]; sacc+=X[B+2]; sacc+=X[B+3]; DV[DI]=cvtpk_s(X[B],X[B+1]); DV[DI+1]=cvtpk_s(X[B+2],X[B+3]); PIN(sacc); PIN(DV); SBAR(); }while(0)
  #define STEP(SP,SN,t,GK,GV,GL) do{ SBAR(); \
    const lds_cptr vp_=vp0+2*sl_prev; \
    VRD(0); SBAR(); GAPA(c0=__builtin_amdgcn_mfma_f32_32x32x16_bf16(kf[0],qr[0],zc,0,0,0)); \
    VRD(4); SBAR(); GAPA(c1=__builtin_amdgcn_mfma_f32_32x32x16_bf16(kf[1],qr[0],zc,0,0,0)); \
    VRD(1); SBAR(); GAPA(c0=__builtin_amdgcn_mfma_f32_32x32x16_bf16(kf[2],qr[1],c0,0,0,0)); \
    VRD(5); SBAR(); GAPA(c1=__builtin_amdgcn_mfma_f32_32x32x16_bf16(kf[3],qr[1],c1,0,0,0)); \
    VRD(2); SBAR(); GAPA(c0=__builtin_amdgcn_mfma_f32_32x32x16_bf16(kf[4],qr[2],c0,0,0,0)); \
    VRD(6); SBAR(); GAPA(c1=__builtin_amdgcn_mfma_f32_32x32x16_bf16(kf[5],qr[2],c1,0,0,0)); \
    VRD(3); SBAR(); GAPA(c0=__builtin_amdgcn_mfma_f32_32x32x16_bf16(kf[6],qr[3],c0,0,0,0)); \
    VRD(7); SBAR(); GAPA(c1=__builtin_amdgcn_mfma_f32_32x32x16_bf16(kf[7],qr[3],c1,0,0,0)); \
    if(__builtin_constant_p(GK)&&(GK)&&(GV)){ glds16s3(Kh+(long)((t)+3)*KVBLK*ZP,koff,(unsigned)__builtin_amdgcn_readfirstlane(kdst+sl_cur),Vh+(long)((t)+1)*KVBLK*ZP,voff,(unsigned)__builtin_amdgcn_readfirstlane(vdst+2*sl_next)); } \
    else { if(GK){DMA_K((t)+3,sl_cur);} if(GV){DMA_V((t)+1,sl_next);} } \
    { const int jb_=(t)-(NT-4); if(jb_>=-3)dbias(c0,c1,jb_,wid,r32,hi,tbl); } \
    if constexpr(NOMAX){ SBAR(); float sacc=0.f; \
      GAPB(o[0]=__builtin_amdgcn_mfma_f32_32x32x16_bf16(PAF(SP,0),VFR(0),o[0],0,0,0), c0,0,SN##0,0); VRDB(0); \
      GAPB(o[1]=__builtin_amdgcn_mfma_f32_32x32x16_bf16(PAF(SP,0),VFR(4),o[1],0,0,0), c0,2,SN##0,1); VRDB(4); \
      KRD(GL,0); GAPB(o[0]=__builtin_amdgcn_mfma_f32_32x32x16_bf16(PAF(SP,1),VFR(1),o[0],0,0,0), c0,4,SN##0,2); VRDB(1); \
      KRD(GL,1); GAPB(o[1]=__builtin_amdgcn_mfma_f32_32x32x16_bf16(PAF(SP,1),VFR(5),o[1],0,0,0), c0,6,SN##0,3); VRDB(5); \
      KRD(GL,2); GAPB(o[0]=__builtin_amdgcn_mfma_f32_32x32x16_bf16(PAF(SP,2),VFR(2),o[0],0,0,0), c0,8,SN##1,0); VRDB(2); \
      KRD(GL,3); GAPB(o[1]=__builtin_amdgcn_mfma_f32_32x32x16_bf16(PAF(SP,2),VFR(6),o[1],0,0,0), c0,10,SN##1,1); VRDB(6); \
      GAPB(o[0]=__builtin_amdgcn_mfma_f32_32x32x16_bf16(PAF(SP,3),VFR(3),o[0],0,0,0), c0,12,SN##1,2); VRDB(3); \
      GAPB(o[1]=__builtin_amdgcn_mfma_f32_32x32x16_bf16(PAF(SP,3),VFR(7),o[1],0,0,0), c0,14,SN##1,3); VRDB(7); \
      GAPB(o[2]=__builtin_amdgcn_mfma_f32_32x32x16_bf16(PAF(SP,0),VFR(0),o[2],0,0,0), c1,0,SN##2,0); \
      GAPB(o[3]=__builtin_amdgcn_mfma_f32_32x32x16_bf16(PAF(SP,0),VFR(4),o[3],0,0,0), c1,2,SN##2,1); \
      GAPB(o[2]=__builtin_amdgcn_mfma_f32_32x32x16_bf16(PAF(SP,1),VFR(1),o[2],0,0,0), c1,4,SN##2,2); \
      GAPB(o[3]=__builtin_amdgcn_mfma_f32_32x32x16_bf16(PAF(SP,1),VFR(5),o[3],0,0,0), c1,6,SN##2,3); \
      GAPB(o[2]=__builtin_amdgcn_mfma_f32_32x32x16_bf16(PAF(SP,2),VFR(2),o[2],0,0,0), c1,8,SN##3,0); \
      GAPB(o[3]=__builtin_amdgcn_mfma_f32_32x32x16_bf16(PAF(SP,2),VFR(6),o[3],0,0,0), c1,10,SN##3,1); \
      GAPB(o[2]=__builtin_amdgcn_mfma_f32_32x32x16_bf16(PAF(SP,3),VFR(3),o[2],0,0,0), c1,12,SN##3,2); \
      GAPB(o[3]=__builtin_amdgcn_mfma_f32_32x32x16_bf16(PAF(SP,3),VFR(7),o[3],0,0,0), c1,14,SN##3,3); \
      l_reg+=sacc; \
    } else { \
    SBAR(); \
      \
    o[0]=__builtin_amdgcn_mfma_f32_32x32x16_bf16(PAF(SP,0),VFR(0),o[0],0,0,0); VRDB(0); float a=MX3(c0[0],c0[1],c1[0]),b=MX3(c0[2],c0[3],c1[1]); a=MX3(a,c1[2],c1[3]); SBAR(); \
    o[1]=__builtin_amdgcn_mfma_f32_32x32x16_bf16(PAF(SP,0),VFR(4),o[1],0,0,0); VRDB(4); a=MX3(a,c0[4],c0[5]);b=MX3(b,c0[6],c0[7]);a=MX3(a,c1[4],c1[5]);b=MX3(b,c1[6],c1[7]); SBAR(); \
    KRD(GL,0); o[0]=__builtin_amdgcn_mfma_f32_32x32x16_bf16(PAF(SP,1),VFR(1),o[0],0,0,0); VRDB(1); a=MX3(a,c0[8],c0[9]);b=MX3(b,c0[10],c0[11]);a=MX3(a,c1[8],c1[9]);b=MX3(b,c1[10],c1[11]); SBAR(); \
    KRD(GL,1); o[1]=__builtin_amdgcn_mfma_f32_32x32x16_bf16(PAF(SP,1),VFR(5),o[1],0,0,0); VRDB(5); a=MX3(a,c0[12],c0[13]);b=MX3(b,c0[14],c0[15]);a=MX3(a,c1[12],c1[13]);b=MX3(b,c1[14],c1[15]); SBAR(); \
    KRD(GL,2); o[0]=__builtin_amdgcn_mfma_f32_32x32x16_bf16(PAF(SP,2),VFR(2),o[0],0,0,0); VRDB(2); \
    float rm=__builtin_fmaxf(a,b); { auto rr=__builtin_amdgcn_permlane32_swap(__float_as_uint(rm),__float_as_uint(rm),false,false); rm=__builtin_fmaxf(__uint_as_float(rr[0]),__uint_as_float(rr[1])); } \
    resc=false; const float rel=rm-mhat;                \
    if(__builtin_expect(__any(rel>(float)THRL),0)){ const float dl=__builtin_fmaxf(rel,0.f); mhat+=dl; \
      const float f=__builtin_amdgcn_exp2f(-dl); l_reg*=f; if(hi==0)wsf[r32]=f; resc=true; } \
    float ref=mhat; asm volatile("":"+v"(ref):"v"(rm));     \
    SBAR(); \
    KRD(GL,3); o[1]=__builtin_amdgcn_mfma_f32_32x32x16_bf16(PAF(SP,2),VFR(6),o[1],0,0,0); VRDB(6); _Pragma("unroll") for(int r=0;r<6;++r){c0[r]=fsub_s(c0[r],ref);c1[r]=fsub_s(c1[r],ref);} SBAR(); \
    o[0]=__builtin_amdgcn_mfma_f32_32x32x16_bf16(PAF(SP,3),VFR(3),o[0],0,0,0); VRDB(3); _Pragma("unroll") for(int r=6;r<11;++r){c0[r]=fsub_s(c0[r],ref);c1[r]=fsub_s(c1[r],ref);} SBAR(); \
    o[1]=__builtin_amdgcn_mfma_f32_32x32x16_bf16(PAF(SP,3),VFR(7),o[1],0,0,0); VRDB(7); _Pragma("unroll") for(int r=11;r<16;++r){c0[r]=fsub_s(c0[r],ref);c1[r]=fsub_s(c1[r],ref);} SBAR(); \
    float sacc=0.f; \
    GAPB4(o[2]=__builtin_amdgcn_mfma_f32_32x32x16_bf16(PAF(SP,0),VFR(0),o[2],0,0,0), c0,0,SN##0,0); \
    GAPB4(o[3]=__builtin_amdgcn_mfma_f32_32x32x16_bf16(PAF(SP,0),VFR(4),o[3],0,0,0), c0,4,SN##0,2); \
    GAPB4(o[2]=__builtin_amdgcn_mfma_f32_32x32x16_bf16(PAF(SP,1),VFR(1),o[2],0,0,0), c0,8,SN##1,0); \
    GAPB4(o[3]=__builtin_amdgcn_mfma_f32_32x32x16_bf16(PAF(SP,1),VFR(5),o[3],0,0,0), c0,12,SN##1,2); \
    GAPB4(o[2]=__builtin_amdgcn_mfma_f32_32x32x16_bf16(PAF(SP,2),VFR(2),o[2],0,0,0), c1,0,SN##2,0); \
    GAPB4(o[3]=__builtin_amdgcn_mfma_f32_32x32x16_bf16(PAF(SP,2),VFR(6),o[3],0,0,0), c1,4,SN##2,2); \
    GAPB4(o[2]=__builtin_amdgcn_mfma_f32_32x32x16_bf16(PAF(SP,3),VFR(3),o[2],0,0,0), c1,8,SN##3,0); \
    GAPB4(o[3]=__builtin_amdgcn_mfma_f32_32x32x16_bf16(PAF(SP,3),VFR(7),o[3],0,0,0), c1,12,SN##3,2); \
    l_reg+=sacc; } \
    }while(0)
  int t=1;
  for(;t+7<NT;t+=2){
    STEP(pa,pb,t,true,true,true);     WAIT_BAR(3); RESC(); ROT();
    STEP(pb,pa,t+1,true,true,true);   WAIT_BAR(3); RESC(); ROT();
  }
  #define ENDW(tt) do{ if((tt)+3<NT){WAIT_BAR(3);} else if((tt)+2<NT){WAIT_BAR(2);} else {WAIT_BAR(0);} }while(0)
  for(;t+1<NT;t+=2){
    STEP(pa,pb,t,(t+3<NT),(t+1<NT),(t+1<NT));       ENDW(t);   RESC(); ROT();
    STEP(pb,pa,t+1,(t+4<NT),(t+2<NT),(t+2<NT));     ENDW(t+1); RESC(); ROT();
  }
  STEP(pa,pb,NT-1,false,false,false); RESC();
  { SBAR(); pv(o,vb0+2*sl_cur,PAF(pb,0),PAF(pb,1),PAF(pb,2),PAF(pb,3)); pv(o+2,vb0+2*sl_cur+8192,PAF(pb,0),PAF(pb,1),PAF(pb,2),PAF(pb,3)); }
  #undef PKW
  #undef PAF
  #undef VFR
  #undef PIN
  #undef MX3
  #undef GAPA
  #undef GAPB
  #undef GAPB4
  #undef EX
  #undef VRD
  #undef VRDB
  #undef KRD
  #undef STEP
  #undef ENDW
  #undef FIX
  {auto rr=__builtin_amdgcn_permlane32_swap(__float_as_uint(l_reg),__float_as_uint(l_reg),false,false);l_reg=__uint_as_float(rr[0])+__uint_as_float(rr[1]);}
  if(hi==0)wsf[32+r32]=l_reg;asm volatile("s_waitcnt lgkmcnt(0)":::"memory");
  float rli[16];
  #pragma unroll
  for(int r=0;r<16;++r)rli[r]=__builtin_amdgcn_rcpf(wsf[32+crow(r,hi)]);
  { bf16*stg=(bf16*)(shm+D2_OST)+wid*4096;
    #pragma unroll
    for(int r=0;r<16;++r){const int orow=crow(r,hi);
      #pragma unroll
      for(int d0=0;d0<4;++d0){ float val=o[d0][r]*rli[r];
        if(EPI==2){ val=__bfloat162float(stg[orow*128+d0*32+r32])-lam*val; }
        stg[orow*128+d0*32+r32]=__float2bfloat16(val);}} }
  asm volatile("s_waitcnt lgkmcnt(0)\n\ts_barrier":::"memory");
  #undef DMA_K
  #undef DMA_V
  #undef RESC
  #undef ROT
}

#ifndef ATT_SEL_DIFF
#define ATT_SEL_DIFF true
#endif
#ifndef ATT_SEL_FOX
#define ATT_SEL_FOX true
#endif
typedef __attribute__((address_space(3))) unsigned ldsu;
struct AttnParams { const bf16* Z; bf16* MIX; const float* logf2; const float* tab; const float* subg; unsigned* counter; const unsigned* nrm; float lam; float osc; };
#define FULL_BAR() asm volatile("s_waitcnt vmcnt(0) lgkmcnt(0)\n\ts_barrier":::"memory")
__device__ __forceinline__ void fox_scan(const float*lf,int n,char*shm){
  ldsf*csl=(ldsf*)(lds_cptr)shm+LDS_CS/4; ldsf*wsum=(ldsf*)(lds_cptr)shm+(LDS_AUX+64)/4;
  int tid_=threadIdx.x; asm volatile("":"+v"(tid_)); const int tid=tid_,lane=tid&63; const int wid=__builtin_amdgcn_readfirstlane(tid>>6);
  const bool act=32*tid<n; float v[32]; float tot=0.f;
  #pragma unroll
  for(int j=0;j<32;++j)v[j]=0.f;
  if(act){ const f32x4a*p=(const f32x4a*)(lf+32*tid);
    #pragma unroll
    for(int k=0;k<8;++k){const f32x4a a=p[k];v[4*k]=a[0];v[4*k+1]=a[1];v[4*k+2]=a[2];v[4*k+3]=a[3];}
    #pragma unroll
    for(int j=0;j<32;++j){tot+=v[j];v[j]=tot;} }
  float inc=tot;
  #pragma unroll
  for(int o=1;o<64;o<<=1){const float tt=shl_(inc,(lane-o)&63,lane); if(lane>=o)inc+=tt;}
  if(lane==63)wsum[wid]=inc;
  FULL_BAR();
  float off=inc-tot;
  for(int w=0;w<wid;++w)off+=wsum[w];
  if(act){
    #pragma unroll
    for(int k=0;k<8;++k){ f32x4a a; a[0]=v[4*k]+off;a[1]=v[4*k+1]+off;a[2]=v[4*k+2]+off;a[3]=v[4*k+3]+off; *(__attribute__((address_space(3))) f32x4a*)(csl+32*tid+4*k)=a; } }
}
__device__ __forceinline__ void diff_table(const float*tab,int h,char*shm){
  ldsf*tb=(ldsf*)(lds_cptr)shm+D2_TBL/4; int i=threadIdx.x; asm volatile("":"+v"(i));
  const int rel=i-447,n=rel<0?-rel:rel;
  const int f=n<8?n:n<12?8:n<16?9:n<23?10:n<32?11:n<46?12:n<64?13:n<91?14:15;
  const int bucket=(rel>0?16:0)+f;
  tb[i]=(i<511)?(tab[bucket*4+h]-tab[15*4+h])*LOG2E:0.f;
}
__device__ __forceinline__ void diff_finish(bf16*Ow,const float*g,float osc,char*shm){
  int tid_=threadIdx.x; asm volatile("":"+v"(tid_)); const int lane=tid_&63; const int wid=__builtin_amdgcn_readfirstlane(tid_>>6);
  const bf16*st=(const bf16*)(shm+D2_OST)+wid*4096;
  const int ch=lane&15; float ga[8];
  #pragma unroll
  for(int j=0;j<8;++j)ga[j]=g[ch*8+j];
  #pragma unroll
  for(int i=0;i<8;++i){ const int row=i*4+(lane>>4);
    const u32x4 a=*(const u32x4*)(st+row*128+ch*8);
    float va[8];
    #pragma unroll
    for(int j=0;j<4;++j){ va[2*j]=__uint_as_float(a[j]<<16); va[2*j+1]=__uint_as_float(a[j]&0xffff0000u); }
    float ss=0.f;
    #pragma unroll
    for(int j=0;j<8;++j)ss+=va[j]*va[j];
    ss+=shx(ss,1,lane);ss+=shx(ss,2,lane);ss+=shx(ss,4,lane);ss+=shx(ss,8,lane);
    const float r=osc/sqrtf(ss*(1.f/128.f)+1e-5f);
    u32x4 oa;
    #pragma unroll
    for(int j=0;j<4;++j)oa[j]=cvtpk_s(va[2*j]*r*ga[2*j],va[2*j+1]*r*ga[2*j+1]);
    *(u32x4*)(Ow+(long)row*OP+ch*8)=oa; }
}
template<int THRL> __device__ __forceinline__ void attn_phase(char*lds,const AttnParams&P){
  const int tid=threadIdx.x; const int wid=__builtin_amdgcn_readfirstlane(tid>>6);
  volatile ldsu*qw=(volatile ldsu*)(lds_cptr)lds+LDS_AUX/4;
  #define GRAB(dst) do{ if(tid==0){ *qw=atomicAdd(P.counter,1u); } FULL_BAR(); dst=__builtin_amdgcn_readfirstlane((int)*qw); }while(0)
  int idx; GRAB(idx);
  while(ATT_SEL_DIFF&&idx<512){ const int qb=63-(idx>>3),bh=idx&7,b=bh>>2,h=bh&3;
    const bf16*zb=P.Z+(long)b*SEQ*ZP;
    diff_table(P.tab,h,lds);
    float bmax=0.f;
    for(int i=0;i<32;++i)bmax=fmaxf(bmax,fabsf(P.tab[i*4+h]-P.tab[60+h])*LOG2E);
    for(int mp=0;mp<2;++mp){
      const unsigned*nq=P.nrm+((2*2+b)*8+2*h+mp)*2,*nk=P.nrm+((3*2+b)*8+2*h+mp)*2;
      const float nq2=__uint_as_float(nq[0])+__uint_as_float(nq[1]),nk2=__uint_as_float(nk[0])+__uint_as_float(nk[1]);
      const float bound=1.02f*sqrtf(nq2*nk2)+bmax;
      const int fast=__builtin_amdgcn_readfirstlane(bound<60.f?1:0);
      if(fast) attn_unit2<THRL,true>(qb,zb+1536+h*128+mp*64,zb+2048+h*128+mp*64,zb+2560+h*128,lds,mp?2:1,P.lam);
      else     attn_unit2<THRL,false>(qb,zb+1536+h*128+mp*64,zb+2048+h*128+mp*64,zb+2560+h*128,lds,mp?2:1,P.lam); }
    diff_finish(P.MIX+((long)b*SEQ+qb*QB+wid*QBLK)*OP+512+h*128,P.subg,P.osc,lds);
    GRAB(idx);
  }
  while(ATT_SEL_FOX&&idx<1536){ const int j=idx-512,qb=63-(j>>4),bh=j&15,b=bh>>3,h=bh&7;
    const bf16*zb=P.Z+(long)b*SEQ*ZP;
    fox_scan(P.logf2+(long)(b*8+h)*SEQ,256*(qb+1),lds);
    { int tid_=threadIdx.x; asm volatile("":"+v"(tid_)); const int ln=tid_&63,row=tid_>>1,hf=tid_&1;
      const u32x4*qp=(const u32x4*)(zb+h*64+(long)(256*qb+row)*ZP+hf*32),*kp=(const u32x4*)(zb+512+h*64+(long)(256*qb+row)*ZP+hf*32);
      float dot=0.f,qq=0.f;
      #pragma unroll
      for(int i=0;i<4;++i){ const u32x4 a=qp[i],c=kp[i];
        #pragma unroll
        for(int j=0;j<4;++j){ const float q0_=__uint_as_float(a[j]<<16),q1_=__uint_as_float(a[j]&0xffff0000u),k0_=__uint_as_float(c[j]<<16),k1_=__uint_as_float(c[j]&0xffff0000u);
          dot+=q0_*k0_+q1_*k1_; qq+=q0_*q0_+q1_*q1_; } }
      dot+=shx(dot,1,ln); qq+=shx(qq,1,ln);
      #pragma unroll
      for(int o=2;o<64;o<<=1){ dot=fminf(dot,shx(dot,o,ln)); qq=fmaxf(qq,shx(qq,o,ln)); }
      ldsf*st=(ldsf*)(lds_cptr)lds+(LDS_AUX+128)/4; if(ln==0){ st[wid]=dot; st[8+wid]=qq; } }
    FULL_BAR();
    int kt0=0,fastfox=0;
    { const unsigned*nk=P.nrm+((1*2+b)*8+h)*2; cldsf*st=(cldsf*)(lds_cptr)lds+(LDS_AUX+128)/4;
      float dmin=st[0],nq2=st[8];
      #pragma unroll
      for(int w=1;w<8;++w){ dmin=fminf(dmin,st[w]); nq2=fmaxf(nq2,st[8+w]); }
      const float nk2=__uint_as_float(nk[0])+__uint_as_float(nk[1]);
      const float nqk=1.02f*sqrtf(nq2*nk2); fastfox=__builtin_amdgcn_readfirstlane(nqk<60.f?1:0);
      const float thr=nqk-dmin+32.5f;
      cldsf*csl=(cldsf*)(lds_cptr)lds+LDS_CS/4; const float cq=csl[256*qb];
      int lo_=0,hi_=4*qb;
      while(lo_<hi_){ const int mid=(lo_+hi_)>>1; if(csl[64*mid+63]-cq>thr)lo_=mid+1; else hi_=mid; }
      kt0=__builtin_amdgcn_readfirstlane(lo_)&~1; }
    if(fastfox) attn_unit<0,2*THRL,true>(qb,kt0,zb+h*64,zb+512+h*64,zb+1024+h*64,P.MIX+(long)b*SEQ*OP+h*64,lds,0,LDS_OST,0.f);
    else        attn_unit<0,2*THRL,false>(qb,kt0,zb+h*64,zb+512+h*64,zb+1024+h*64,P.MIX+(long)b*SEQ*OP+h*64,lds,0,LDS_OST,0.f);
    GRAB(idx);
  }
  #undef GRAB
}
#undef FULL_BAR
#undef SBAR
#undef WAIT_BAR
}
#include <hip/hip_cooperative_groups.h>
namespace cg = cooperative_groups;
#ifndef MK_ONE_LAUNCH
#define MK_ONE_LAUNCH 1
#endif
constexpr int NWAVES = 8;
constexpr int BATCH = 2, T = 16384, D = 1024, FF = 4096, M = BATCH * T, NIN = 3328, NINSRC = 3080, DEPTH = 2;
constexpr size_t MiB = 1u << 20;
constexpr size_t WS_CTL = 0, CTL_ZERO_BYTES = 65536;
constexpr int CW_BAR = 4096, CW_NRM = 1024;
constexpr size_t WS_WIN = 2 * MiB, WIN_BYTES = (size_t)NIN * D * 2;
constexpr size_t WS_WO = 16 * MiB, WO_BYTES = (size_t)D * D * 2;
constexpr size_t WS_W1 = 20 * MiB, W1_BYTES = (size_t)D * FF * 2;
constexpr size_t WS_W2 = 36 * MiB, W2_BYTES = (size_t)D * FF * 2;
constexpr size_t WS_SSQ = 52 * MiB;
constexpr size_t WS_DUMP = 56 * MiB;
constexpr size_t WS_LOGF = 54 * MiB;
constexpr size_t WS_XB = 64 * MiB;
constexpr size_t WS_MIX = 128 * MiB;
constexpr size_t WS_Z = 192 * MiB;
constexpr size_t WS_H = 128 * MiB;
constexpr size_t WS_END = 384 * MiB;
static_assert(WS_WIN + 2 * WIN_BYTES <= WS_WO && WS_WO + 2 * WO_BYTES <= WS_W1 && WS_W1 + 2 * W1_BYTES <= WS_W2 && WS_W2 + 2 * W2_BYTES <= WS_SSQ, "ws map");
static_assert(WS_H + (size_t)M * FF * 2 <= WS_END && WS_Z + (size_t)M * 3072 * 2 <= WS_END, "ws map 2");
constexpr int RING_BYTES = 131072, EPI_LDS_OFF = RING_BYTES;
constexpr int PARAM_OFF = (attn_body::LDS_TOTAL > RING_BYTES + 4096) ? attn_body::LDS_TOTAL : RING_BYTES + 4096;
constexpr int XB_ST_OFF = PARAM_OFF + 192;
constexpr int LDS_BYTES = PARAM_OFF + 256;
constexpr int RTAB_OFF = RING_BYTES + 4096 + 256;
static_assert(RTAB_OFF + 8 * 256 * 4 <= PARAM_OFF, "rstd table");
static_assert(LDS_BYTES <= 160 * 1024, "LDS");

#define LAS __attribute__((address_space(3)))
typedef unsigned short bf16;
typedef unsigned v4u __attribute__((ext_vector_type(4)));
typedef float f32x4 __attribute__((ext_vector_type(4)));
__device__ __forceinline__ unsigned f2bf(float f) { unsigned u = __builtin_bit_cast(unsigned, f); return (u + 0x7fffu + ((u >> 16) & 1u)) >> 16; }
__device__ __forceinline__ unsigned pk2(float lo, float hi) { return f2bf(lo) | (f2bf(hi) << 16); }
__device__ __forceinline__ float wave_sum(float v, int lane) {
#pragma unroll
    for (int o = 1; o < 64; o <<= 1) v += shx(v, o, lane);
    return v;
}
template <bool MAPIN>
__device__ __forceinline__ void p0_transpose_item(const float* W, int K, int Nsrc, int nblk, const float* gain, bf16* WT, LAS float* scr, int item, int lane) {
    const int kb = item / nblk, nb = item % nblk, k0 = 64 * kb, n0 = 32 * nb;
    const int ch = lane & 7, rr = lane >> 3;
    const int nn = n0 + 4 * ch;
    int src = nn; if (MAPIN) src = nn < 1536 ? nn : (nn < 3072 ? nn + 8 : (nn < 3080 ? nn - 1536 : -1));
    f32x4 v[8];
#pragma unroll
    for (int i = 0; i < 8; ++i) { const int kk = 8 * i + rr; v[i] = (f32x4){0.f, 0.f, 0.f, 0.f}; if (src >= 0) v[i] = *(const f32x4*)(W + (size_t)(k0 + kk) * Nsrc + src); }
#pragma unroll
    for (int i = 0; i < 8; ++i) { const int kk = 8 * i + rr; f32x4 w = v[i]; if (gain) w = w * gain[k0 + kk];
        scr[kk * 33 + 4 * ch + 0] = w[0]; scr[kk * 33 + 4 * ch + 1] = w[1]; scr[kk * 33 + 4 * ch + 2] = w[2]; scr[kk * 33 + 4 * ch + 3] = w[3]; }
    asm volatile("s_waitcnt lgkmcnt(0)" ::: "memory");
    const int c = lane & 7;
#pragma unroll
    for (int j = 0; j < 4; ++j) { const int n = (lane >> 3) + 8 * j; const LAS float* s = scr + (8 * c) * 33 + n;
        v4u o; o.x = pk2(s[0 * 33], s[1 * 33]); o.y = pk2(s[2 * 33], s[3 * 33]); o.z = pk2(s[4 * 33], s[5 * 33]); o.w = pk2(s[6 * 33], s[7 * 33]);
        *(v4u*)(WT + (size_t)(n0 + n) * K + k0 + 8 * c) = o; }
    asm volatile("s_waitcnt lgkmcnt(0)" ::: "memory");
}

#define XB_TMO      128
#define XB_XCNT(j)  (256  + 64 * (j))
#define XB_XSUB(j)  (1280 + 64 * (j))
#define XB_XGEN(j)  (2304 + 64 * (j))
#define XB_TOP      3328
#define XB_TOPGEN   3392
#define XCD_BAR_WORDS 3456
#define XB_SPIN_CAP (1u << 18)

__device__ __forceinline__ unsigned xb_ld(unsigned* p)              { return __hip_atomic_load(p, __ATOMIC_RELAXED, __HIP_MEMORY_SCOPE_AGENT); }
__device__ __forceinline__ unsigned xb_add(unsigned* p, unsigned v) { return __hip_atomic_fetch_add(p, v, __ATOMIC_RELAXED, __HIP_MEMORY_SCOPE_AGENT); }
__device__ __forceinline__ unsigned xb_xcc_id() { return (unsigned)__builtin_amdgcn_s_getreg((3 << 11) | 20) & 0xFu; }
#define XB_SPIN(cond, bar) do { unsigned _sp = 0; while (cond) { __builtin_amdgcn_s_sleep(1); \
    if ((++_sp & 255u) == 0u) { if (xb_ld(&(bar)[XB_TMO])) break; if (_sp > XB_SPIN_CAP) { atomicAdd(&(bar)[XB_TMO], 1u); break; } } } } while (0)

struct XcdBarrier {
    unsigned* bar; unsigned x;
    volatile LAS unsigned* st;
};

__device__ __forceinline__ XcdBarrier xcd_barrier_post(unsigned* bar, volatile LAS unsigned* st) {
    XcdBarrier b; b.bar = bar; b.x = xb_xcc_id(); b.st = st;
    if (threadIdx.x == 0) (void)xb_add(&bar[XB_XCNT(b.x)], 1u);
    return b;
}
__device__ __forceinline__ void xcd_barrier_complete(unsigned* bar, unsigned x, unsigned& nloc, unsigned& nx) {
    const unsigned G = gridDim.x * gridDim.y * gridDim.z;
    unsigned sum, cnt, mine, sp = 0u;
    for (;;) {
        sum = 0u; cnt = 0u; mine = 0u;
#pragma unroll
        for (unsigned j = 0; j < 16; ++j) { const unsigned c = xb_ld(&bar[XB_XCNT(j)]); sum += c; cnt += (c > 0u) ? 1u : 0u; mine = (j == x) ? c : mine; }
        if (sum == G) break;
        __builtin_amdgcn_s_sleep(1);
        if ((++sp & 255u) == 0u) { if (xb_ld(&bar[XB_TMO])) break; if (sp > XB_SPIN_CAP) { atomicAdd(&bar[XB_TMO], 1u); break; } }
    }
    nloc = mine > 0u ? mine : 1u; nx = cnt > 0u ? cnt : 1u;
}

__device__ __forceinline__ void xcd_barrier(const XcdBarrier& b) {
    asm volatile("s_waitcnt vmcnt(0)" ::: "memory");
    __syncthreads();
    if (threadIdx.x == 0) {
        unsigned* bar = b.bar;
        __builtin_amdgcn_s_waitcnt(0);
        unsigned nloc = b.st[0], nx = b.st[1];
        if (nloc == 0u) { xcd_barrier_complete(bar, b.x, nloc, nx); b.st[0] = nloc; b.st[1] = nx; }
        const unsigned old = xb_add(&bar[XB_XSUB(b.x)], 1u);
        const unsigned gen = old / nloc;
        if (old + 1u == (gen + 1u) * nloc) {
            __builtin_amdgcn_fence(__ATOMIC_RELEASE, "agent");
            asm volatile("s_waitcnt vmcnt(0)" ::: "memory");
            const unsigned og = xb_add(&bar[XB_TOP], 1u);
            const unsigned tg = og / nx;
            if (og + 1u == (tg + 1u) * nx) xb_add(&bar[XB_TOPGEN], 1u);
            else XB_SPIN(xb_ld(&bar[XB_TOPGEN]) == tg, bar);
            __builtin_amdgcn_fence(__ATOMIC_ACQUIRE, "agent");
            xb_add(&bar[XB_XGEN(b.x)], 1u);
            asm volatile("s_waitcnt vmcnt(0)" ::: "memory");
        } else {
            XB_SPIN(xb_ld(&bar[XB_XGEN(b.x)]) == gen, bar);
            __builtin_amdgcn_fence(__ATOMIC_ACQUIRE, "agent");
            asm volatile("s_waitcnt vmcnt(0)" ::: "memory");
        }
    }
    __syncthreads();
}

__device__ __forceinline__ int opqv(int v) { asm volatile("" : "+v"(v)); return v; }
__device__ __forceinline__ int opq(int v) { asm volatile("" : "+s"(v)); return v; }
__device__ __forceinline__ const float* ldprm(LAS unsigned char* l, int i) {
    volatile LAS unsigned* p = (volatile LAS unsigned*)(l + PARAM_OFF) + 2 * i; unsigned a = p[0], b = p[1];
    a = __builtin_amdgcn_readfirstlane(a); b = __builtin_amdgcn_readfirstlane(b);
    return (const float*)(const __attribute__((address_space(1))) float*)(((unsigned long long)b << 32) | a);
}
struct Args { const float* in[15]; float* out; unsigned char* ws; int ph_lo, ph_hi; };
__global__ void __launch_bounds__(NWAVES * 64, 2) fwd_megakernel(Args args) {
    extern __shared__ __attribute__((aligned(16))) unsigned char lds[];
    LAS unsigned char* ldsl = (LAS unsigned char*)lds;
    const int tid = threadIdx.x, wave = __builtin_amdgcn_readfirstlane(tid >> 6);
#define lane (opqv((int)threadIdx.x) & 63)
    const int G = gridDim.x;
    if (tid == 0) { volatile LAS unsigned long long* pp = (volatile LAS unsigned long long*)(ldsl + PARAM_OFF);
#pragma unroll
        for (int i = 0; i < 15; ++i) pp[i] = (unsigned long long)args.in[i];
        pp[15] = (unsigned long long)args.out; pp[16] = (unsigned long long)args.ws;
        ((volatile LAS unsigned*)(ldsl + XB_ST_OFF))[0] = 0u; ((volatile LAS unsigned*)(ldsl + XB_ST_OFF))[1] = 0u; }
    __syncthreads();
    (void)xcd_barrier_post((unsigned*)(args.ws + WS_CTL) + CW_BAR, (volatile LAS unsigned*)(ldsl + XB_ST_OFF));
#define INP(i) ldprm(ldsl, (i))
#define OUTP ((float*)ldprm(ldsl, 15))
#define WSP ((unsigned char*)ldprm(ldsl, 16))
#define XB ((bf16*)(ws + WS_XB))
#define MIX ((bf16*)(ws + WS_MIX))
#define Z ((bf16*)(ws + WS_Z))
#define HB ((bf16*)(ws + WS_H))
#define SSQ ((float*)(ws + WS_SSQ))
#define LOGF ((float*)(ws + WS_LOGF))
    const int lo = args.ph_lo, hi = args.ph_hi;
#ifndef PHMASK
#define PHMASK 0xfff
#endif
#define IN(k) (((PHMASK >> ((k) > 5 && (k) < 11 ? (k) - 5 : (k))) & 1) && lo <= (k) && (k) < hi)
#ifndef DUPMASK
#define DUPMASK 0
#endif
#define REPS(bit) ((((DUPMASK) >> (bit)) & 1) + 1)
#define SEAM(k) do { if (IN(k) && IN((k) + 1)) { if (lo < 0) cg::this_grid().sync(); else { XcdBarrier xb_; xb_.bar = (unsigned*)(WSP + WS_CTL) + CW_BAR; xb_.x = xb_xcc_id(); xb_.st = (volatile LAS unsigned*)(ldsl + XB_ST_OFF); xcd_barrier(xb_); } } } while (0)

    if (IN(0)) {
        LAS float* scr = (LAS float*)(ldsl + wave * 16384); unsigned char* ws = WSP; const float* x_in = INP(0);
        const float *w_in = INP(1), *w_out = INP(8), *g_att = INP(9), *g_mlp = INP(10), *w_1 = INP(11), *w_2 = INP(12);
        const int gw = blockIdx.x * NWAVES + wave, NGW = G * NWAVES;
        constexpr int I_IN = (D / 64) * (NIN / 32), I_O = (D / 64) * (D / 32), I_1 = (D / 64) * (FF / 32), I_2 = (FF / 64) * (D / 32), I_L = I_IN + I_O + I_1 + I_2;
        for (int it = gw; it < DEPTH * I_L; it += NGW) {
            const int l = it / I_L; int r = it % I_L;
            if (r < I_IN) { p0_transpose_item<true>(w_in + (size_t)l * D * NINSRC, D, NINSRC, NIN / 32, g_att + l * D, (bf16*)(ws + WS_WIN + l * WIN_BYTES), scr, r, lane); continue; } r -= I_IN;
            if (r < I_O) { p0_transpose_item<false>(w_out + (size_t)l * D * D, D, D, D / 32, nullptr, (bf16*)(ws + WS_WO + l * WO_BYTES), scr, r, lane); continue; } r -= I_O;
            if (r < I_1) { p0_transpose_item<false>(w_1 + (size_t)l * D * FF, D, FF, FF / 32, g_mlp + l * D, (bf16*)(ws + WS_W1 + l * W1_BYTES), scr, r, lane); continue; } r -= I_1;
            p0_transpose_item<false>(w_2 + (size_t)l * FF * D, FF, D, D / 32, nullptr, (bf16*)(ws + WS_W2 + l * W2_BYTES), scr, r, lane);
        }
        for (int m0 = gw * 4; m0 < M; m0 += NGW * 4) {
            const int ln = lane; f32x4 v[4][4]; float s[4];
#pragma unroll
            for (int q = 0; q < 4; ++q) { const f32x4* xr = (const f32x4*)(x_in + (size_t)(m0 + q) * D) + ln;
#pragma unroll
                for (int j = 0; j < 4; ++j) v[q][j] = xr[64 * j]; }
#pragma unroll
            for (int q = 0; q < 4; ++q) { float a = 0.f;
#pragma unroll
                for (int j = 0; j < 4; ++j) a += (v[q][j][0] * v[q][j][0] + v[q][j][1] * v[q][j][1]) + (v[q][j][2] * v[q][j][2] + v[q][j][3] * v[q][j][3]);
                s[q] = wave_sum(a, ln); }
#pragma unroll
            for (int q = 0; q < 4; ++q) { unsigned long long* o8 = (unsigned long long*)(XB + (size_t)(m0 + q) * D) + ln;
#pragma unroll
                for (int j = 0; j < 4; ++j) o8[64 * j] = (unsigned long long)pk2(v[q][j][0], v[q][j][1]) | ((unsigned long long)pk2(v[q][j][2], v[q][j][3]) << 32);
                if (ln == 0) *(f32x4*)(SSQ + (size_t)(m0 + q) * 4) = (f32x4){s[q], 0.f, 0.f, 0.f}; }
        }
    }
    SEAM(0);
    for (int l = 0; l < DEPTH; ++l) {
        const int pb = 1 + 5 * l;
        for (int rp = 0; rp < REPS(1); ++rp) { if (rp) cg::this_grid().sync();
        if (IN(pb)) { unsigned char* ws = WSP;
            pg8::Gemm g{XB, (const bf16*)(ws + WS_WIN + l * WIN_BYTES), M, 3072, D}; pg8::StaticOrder S; S.init(M, 3072, G, opq((int)blockIdx.x));
            { LAS float* rt = (LAS float*)(ldsl + RTAB_OFF); pg8::Unit uu;
              for (int i = (opqv((int)threadIdx.x) >> 8); S.next(i, uu); i += 2) { const int r = opqv((int)threadIdx.x) & 255; rt[i * 256 + r] = pg8::row_rstd(SSQ, uu.pm * 256 + r); }
              __syncthreads(); }
            pg8::EpiInProj E{Z, (const LAS float*)(ldsl + RTAB_OFF), SSQ, INP(2) + l * 8, LOGF, (unsigned*)(ws + WS_CTL) + CW_NRM + 128 * l};
            pg8::gemm_phase<pg8::EpiInProj, pg8::StaticOrder, true, true>(ldsl, g, S, E);
            { const int ln = lane, row = ln & 15, quad = ln >> 4; const float* bfp = INP(2) + l * 8; const bf16* wf = (const bf16*)(ws + WS_WIN + l * WIN_BYTES) + (size_t)(3072 + row) * D + quad * 8;
              for (int rb = opq((int)blockIdx.x) * NWAVES + wave; rb < M / 16; rb += G * NWAVES) {
                const int m0 = rb * 16; const bf16* ap = XB + (size_t)(m0 + row) * D + quad * 8; pg8::f32x4 acc = {0.f, 0.f, 0.f, 0.f};
#pragma unroll 8
                for (int k0 = 0; k0 < D; k0 += 32) acc = __builtin_amdgcn_mfma_f32_16x16x32_bf16(*(const pg8::bf16x8*)(ap + k0), *(const pg8::bf16x8*)(wf + k0), acc, 0, 0, 0);
                if (row < 8) {
#pragma unroll
                    for (int rg = 0; rg < 4; ++rg) { const int m = m0 + quad * 4 + rg; const float z = acc[rg] * pg8::row_rstd(SSQ, m) + bfp[row];
                        const float ls = fminf(z, 0.f) - log1pf(expf(-fabsf(z)));
                        LOGF[(size_t)((m >> 14) * 8 + row) * T + (m & (T - 1))] = ls * 1.4426950408889634f; } } } }
        } }
        SEAM(pb);
        for (int rp = 0; rp < REPS(2); ++rp) { if (rp) cg::this_grid().sync();
        if (IN(pb + 1)) { unsigned char* ws = WSP;
            float d1 = INP(3)[l * 64 + lane] * INP(4)[l * 64 + lane], d2 = INP(5)[l * 64 + lane] * INP(6)[l * 64 + lane];
            d1 = wave_sum(d1, lane); d2 = wave_sum(d2, lane);
            const float li = 0.8f - 0.6f * expf(-0.3f * (float)l);
            attn_body::AttnParams P{(const attn_body::bf16*)Z, (attn_body::bf16*)MIX, LOGF, INP(13), INP(7) + l * 128, (unsigned*)(ws + WS_CTL) + 64 * (1 + l) + 16 * rp, (const unsigned*)(ws + WS_CTL) + CW_NRM + 128 * l, expf(d1) - expf(d2) + li, 1.0f - li};
            attn_body::attn_phase<8>((char*)lds, P);
        } }
        SEAM(pb + 1);
        if (IN(pb + 2)) { unsigned char* ws = WSP; float* out = OUTP;
            pg8::Gemm g{MIX, (const bf16*)(ws + WS_WO + l * WO_BYTES), M, D, D}; pg8::StaticOrder S; S.init(M, D, G, opq((int)blockIdx.x));
            pg8::EpiResid E{XB, SSQ, (LAS float*)(ldsl + EPI_LDS_OFF)};
            pg8::gemm_phase<pg8::EpiResid, pg8::StaticOrder, true, true>(ldsl, g, S, E);
        }
        SEAM(pb + 2);
        for (int rp = 0; rp < REPS(4); ++rp) { if (rp) cg::this_grid().sync();
        if (IN(pb + 3)) { unsigned char* ws = WSP;
            pg8::Gemm g{XB, (const bf16*)(ws + WS_W1 + l * W1_BYTES), M, FF, D}; pg8::StaticOrder S; S.init(M, FF, G, opq((int)blockIdx.x));
            { LAS float* rt = (LAS float*)(ldsl + RTAB_OFF); pg8::Unit uu;
              for (int i = (opqv((int)threadIdx.x) >> 8); S.next(i, uu); i += 2) { const int r = opqv((int)threadIdx.x) & 255; rt[i * 256 + r] = pg8::row_rstd(SSQ, uu.pm * 256 + r); }
              __syncthreads(); }
            pg8::EpiRelu2 E{HB, (const LAS float*)(ldsl + RTAB_OFF)};
            pg8::gemm_phase<pg8::EpiRelu2, pg8::StaticOrder, true, true>(ldsl, g, S, E);
        } }
        SEAM(pb + 3);
        if (IN(pb + 4)) { unsigned char* ws = WSP; float* out = OUTP;
            pg8::Gemm g{HB, (const bf16*)(ws + WS_W2 + l * W2_BYTES), M, D, FF}; pg8::StaticOrder S; S.init(M, D, G, opq((int)blockIdx.x));
            pg8::EpiResid E{XB, SSQ, (LAS float*)(ldsl + EPI_LDS_OFF)};
            pg8::gemm_phase<pg8::EpiResid, pg8::StaticOrder, true, true>(ldsl, g, S, E);
        }
        SEAM(pb + 4);
    }
    if (IN(11)) { float* out = OUTP; unsigned char* ws = WSP;
        const int gw = blockIdx.x * NWAVES + wave, NGW = G * NWAVES; const int ln = lane;
        f32x4 gv[2][2];
#pragma unroll
        for (int j = 0; j < 2; ++j) { gv[j][0] = *(const f32x4*)(INP(14) + 8 * (ln + 64 * j)); gv[j][1] = *(const f32x4*)(INP(14) + 8 * (ln + 64 * j) + 4); }
        for (int m0 = gw * 4; m0 < M; m0 += NGW * 4) {
            v4u v[4][2]; f32x4 q[4];
#pragma unroll
            for (int r = 0; r < 4; ++r) { const v4u* xr = (const v4u*)(XB + (size_t)(m0 + r) * D) + ln; v[r][0] = xr[0]; v[r][1] = xr[64]; q[r] = *(const f32x4*)(SSQ + (size_t)(m0 + r) * 4); }
#pragma unroll
            for (int r = 0; r < 4; ++r) { const float rs = 1.0f / sqrtf(((q[r][0] + q[r][1]) + (q[r][2] + q[r][3])) * (1.0f / D) + 1e-5f);
#pragma unroll
                for (int j = 0; j < 2; ++j) { const v4u w = v[r][j];
                    const f32x4 a = {__builtin_bit_cast(float, w.x << 16), __builtin_bit_cast(float, w.x & 0xffff0000u), __builtin_bit_cast(float, w.y << 16), __builtin_bit_cast(float, w.y & 0xffff0000u)};
                    const f32x4 b = {__builtin_bit_cast(float, w.z << 16), __builtin_bit_cast(float, w.z & 0xffff0000u), __builtin_bit_cast(float, w.w << 16), __builtin_bit_cast(float, w.w & 0xffff0000u)};
                    f32x4* o = (f32x4*)(out + (size_t)(m0 + r) * D + 8 * (ln + 64 * j)); o[0] = a * rs * gv[j][0]; o[1] = b * rs * gv[j][1]; } }
        }
    }
#undef IN
#undef SEAM
}

extern "C" void kernel_launch(void* const* d_in, const int* in_sizes, int n_in, void* d_out, int out_size, void* d_ws, size_t ws_size, hipStream_t stream) {
    static int grid = 0;
    if (grid == 0) {
        if (n_in != 15 || in_sizes[0] != M * D || out_size != M * D || ws_size < WS_END) { fprintf(stderr, "kernel_launch: unexpected shapes / workspace (n_in %d, ws %zu)\n", n_in, ws_size); grid = -1; return; }
        int dev = 0, cus = 0, per_cu = 0;
        hipGetDevice(&dev); hipDeviceGetAttribute(&cus, hipDeviceAttributeMultiprocessorCount, dev);
        if (hipFuncSetAttribute((const void*)fwd_megakernel, hipFuncAttributeMaxDynamicSharedMemorySize, LDS_BYTES) != hipSuccess) { fprintf(stderr, "kernel_launch: hipFuncSetAttribute failed\n"); grid = -1; return; }
        hipOccupancyMaxActiveBlocksPerMultiprocessor(&per_cu, (const void*)fwd_megakernel, NWAVES * 64, LDS_BYTES);
        (void)hipGetLastError();
        if (per_cu < 1) per_cu = 1;
        grid = cus * per_cu;
        fprintf(stderr, "kernel_launch: grid %d (%d CUs x %d)\n", grid, cus, per_cu);
    }
    if (grid < 0) return;
    hipMemsetAsync((char*)d_ws + WS_CTL, 0, CTL_ZERO_BYTES, stream);
    Args a{};
    for (int i = 0; i < 15; ++i) a.in[i] = (const float*)d_in[i];
    a.out = (float*)d_out; a.ws = (unsigned char*)d_ws;
#if MK_ONE_LAUNCH
    a.ph_lo = 0; a.ph_hi = 12;
    void* kargs[] = {&a};
    hipError_t e = hipLaunchCooperativeKernel((const void*)fwd_megakernel, dim3(grid), dim3(NWAVES * 64), kargs, LDS_BYTES, stream);
    if (e != hipSuccess) fprintf(stderr, "cooperative launch failed: %s (grid %d)\n", hipGetErrorString(e), grid);
#else
    for (int p = 0; p < 12; ++p) { a.ph_lo = p; a.ph_hi = p + 1; hipLaunchKernelGGL(fwd_megakernel, dim3(grid), dim3(NWAVES * 64), LDS_BYTES, stream, a); }
#endif
}
```

```cpp
#include <hip/hip_runtime.h>
#include <cstdio>
#include <cstdint>
__device__ __forceinline__ float shx(float v, int k, int lane) { return __builtin_bit_cast(float, __builtin_amdgcn_ds_bpermute((lane ^ k) << 2, __builtin_bit_cast(int, v))); }
__device__ __forceinline__ float shl_(float v, int src, int lane) { (void)lane; return __builtin_bit_cast(float, __builtin_amdgcn_ds_bpermute(src << 2, __builtin_bit_cast(int, v))); }
namespace pg8 {
#define PG8_LAS __attribute__((address_space(3)))
typedef unsigned short bf16_t;
typedef short bf16x8 __attribute__((ext_vector_type(8)));
typedef float f32x4 __attribute__((ext_vector_type(4)));
typedef unsigned u32x4 __attribute__((ext_vector_type(4)));
constexpr int BM = 256, BK = 64, HALF = 128, HTB = HALF * BK * 2  , STAGE_BYTES = 8 * HTB, NXCD = 8, WGM = 8;

__host__ __device__ __forceinline__ int lds_byte(int r, int c) { const int st = (r >> 4) * 2 + (c >> 5), rr = r & 15, cc = c & 31, ob = rr * 64 + cc * 2; return st * 1024 + (ob ^ (((ob >> 9) & 1) << 5)); }
__host__ __device__ __forceinline__ void stage_rc(int b, int& R, int& C) { const int st = b / 1024, sb = b % 1024, swz = sb ^ (((sb >> 9) & 1) << 5); R = (st >> 1) * 16 + swz / 64; C = (st & 1) * 32 + (swz % 64) / 2; }
__host__ __device__ __forceinline__ int perm32(int rho) { const int n = rho >> 4, i = rho & 15; return 8 * (i >> 2) + 4 * n + (i & 3); }

struct Unit { int pm, pn; };
struct Gemm { const bf16_t* A; const bf16_t* Bt; int M, N, K; };

struct StaticOrder {
    int nM, nN, nwg, G, c;
    __host__ __device__ void init(int M, int N, int G_, int c_) { nM = M / BM; nN = N / BM; nwg = nM * nN; G = G_; c = c_; }
    __host__ __device__ bool next(int i, Unit& u) const {
        const long L = (long)i * G + c; if (L >= nwg) return false;
        int wgid = (int)L; { const int q = nwg / NXCD, r = nwg % NXCD, xcd = wgid % NXCD, off = wgid / NXCD; wgid = (xcd < r ? xcd * (q + 1) : r * (q + 1) + (xcd - r) * q) + off; }
        const int nig = WGM * nN, gid = wgid / nig, fm = gid * WGM, gsz = (nM - fm) < WGM ? (nM - fm) : WGM;
        u.pm = fm + ((wgid % nig) % gsz); u.pn = (wgid % nig) / gsz; return true;
    }
    __device__ __forceinline__ void a_ready(const Unit&) const {}
    __device__ __forceinline__ void done(const Unit&) const {}
};

__device__ __forceinline__ unsigned cvt_pk_bf16(float lo, float hi) { unsigned r; asm volatile("v_cvt_pk_bf16_f32 %0, %1, %2" : "=v"(r) : "v"(lo), "v"(hi)); return r; }
typedef float f32x2 __attribute__((ext_vector_type(2)));
typedef unsigned u32x2 __attribute__((ext_vector_type(2)));
constexpr float QC2 = 0.125f * 1.4426950408889634f;
constexpr int ZPITCH = 3072, SEQ_ = 16384;
__device__ __forceinline__ float row_rstd(const float* ssq, int row) {
    const f32x4 q = *(const f32x4*)(ssq + (size_t)row * 4); return 1.0f / sqrtf(((q[0] + q[1]) + (q[2] + q[3])) * (1.0f / 1024.0f) + 1e-5f);
}
struct EpiInProj {
    static constexpr bool PERM = true, AFTER_DRAIN = false;
    bf16_t* Z; const PG8_LAS float* rtab;     const float* ssq; const float* bf; float* logf2; unsigned* nrm;
    __device__ __forceinline__ void operator()(const f32x4 (&acc)[2][2][4][2], const Unit& u, int wr, int wc, int fr, int fq, int ui) const {
        const int row0 = u.pm * BM + wr * 64 + fr;
        float rs[2][4];
#pragma unroll
        for (int ai = 0; ai < 2; ++ai)
#pragma unroll
            for (int m = 0; m < 4; ++m) rs[ai][m] = rtab[ui * 256 + wr * 64 + fr + ai * HALF + m * 16];
        if (u.pn < 12) {
            const float sc = (u.pn < 2 || u.pn == 6 || u.pn == 7) ? QC2 : 1.f;
            const int col0 = u.pn * BM + wc * 32 + 8 * fq;
#pragma unroll
            for (int ai = 0; ai < 2; ++ai)
#pragma unroll
                for (int m = 0; m < 4; ++m) { bf16_t* rowp = Z + (size_t)(row0 + ai * HALF + m * 16) * ZPITCH + col0; const float s = rs[ai][m] * sc;
#pragma unroll
                    for (int bj = 0; bj < 2; ++bj) { const f32x4 v0 = acc[ai][bj][m][0] * s, v1 = acc[ai][bj][m][1] * s; u32x4 w;
                        w.x = cvt_pk_bf16(v0[0], v0[1]); w.y = cvt_pk_bf16(v0[2], v0[3]); w.z = cvt_pk_bf16(v1[0], v1[1]); w.w = cvt_pk_bf16(v1[2], v1[3]);
                        *(u32x4*)(rowp + bj * HALF) = w; } }
            if ((u.pn >= 2 && u.pn < 4) || (u.pn >= 6 && u.pn < 10)) {
                const int which = u.pn < 4 ? (u.pn >> 1) : 2 + ((u.pn - 6) >> 1);
                float mx[2] = {0.f, 0.f};
#pragma unroll
                for (int ai = 0; ai < 2; ++ai)
#pragma unroll
                    for (int m = 0; m < 4; ++m) { const float s = rs[ai][m] * sc;
#pragma unroll
                        for (int bj = 0; bj < 2; ++bj) { const f32x4 v0 = acc[ai][bj][m][0] * s, v1 = acc[ai][bj][m][1] * s;
                            float p = (v0[0] * v0[0] + v0[1] * v0[1]) + (v0[2] * v0[2] + v0[3] * v0[3]) + (v1[0] * v1[0] + v1[1] * v1[1]) + (v1[2] * v1[2] + v1[3] * v1[3]);
                            p += shx(p, 16, fr + 16 * fq); p += shx(p, 32, fr + 16 * fq); mx[bj] = fmaxf(mx[bj], p); } }
#pragma unroll
                for (int bj = 0; bj < 2; ++bj) { float m = mx[bj]; { const int ln = fr + 16 * fq; m = fmaxf(m, shx(m, 1, ln)); m = fmaxf(m, shx(m, 2, ln)); m = fmaxf(m, shx(m, 4, ln)); m = fmaxf(m, shx(m, 8, ln)); }
                    if (fr == 0 && fq == 0) atomicMax(nrm + (((which * 2 + (u.pm >> 6)) * 8 + (u.pn & 1) * 4 + bj * 2 + (wc >> 1)) * 2 + (wc & 1)), __float_as_uint(m)); }
            }
        } else if (wc == 0 && fq == 0) {
#pragma unroll
            for (int ai = 0; ai < 2; ++ai)
#pragma unroll
                for (int m = 0; m < 4; ++m) { const int row = row0 + ai * HALF + m * 16, b = row / SEQ_, s = row % SEQ_; const float r = rs[ai][m];
#pragma unroll
                    for (int j = 0; j < 8; ++j) { const float a = (j < 4) ? acc[ai][0][m][0][j & 3] : acc[ai][0][m][1][j & 3]; const float z = a * r + bf[j];
                        const float ls = fminf(z, 0.f) - log1pf(expf(-fabsf(z)));
                        logf2[(size_t)(b * 8 + j) * SEQ_ + s] = ls * 1.4426950408889634f; } }
        }
    }
};
struct EpiRelu2 {
    static constexpr bool PERM = true, AFTER_DRAIN = false;
    bf16_t* H; const PG8_LAS float* rtab;
    __device__ __forceinline__ void operator()(const f32x4 (&acc)[2][2][4][2], const Unit& u, int wr, int wc, int fr, int fq, int ui) const {
        const int row0 = u.pm * BM + wr * 64 + fr, col0 = u.pn * BM + wc * 32 + 8 * fq;
#pragma unroll
        for (int ai = 0; ai < 2; ++ai)
#pragma unroll
            for (int m = 0; m < 4; ++m) { const int row = row0 + ai * HALF + m * 16; const float s = rtab[ui * 256 + wr * 64 + fr + ai * HALF + m * 16]; bf16_t* rowp = H + (size_t)row * 4096 + col0;
#pragma unroll
                for (int bj = 0; bj < 2; ++bj) { f32x4 v0 = acc[ai][bj][m][0] * s, v1 = acc[ai][bj][m][1] * s;
#pragma unroll
                    for (int e = 0; e < 4; ++e) { const float a = fmaxf(v0[e], 0.f), b = fmaxf(v1[e], 0.f); v0[e] = a * a; v1[e] = b * b; }
                    u32x4 w; w.x = cvt_pk_bf16(v0[0], v0[1]); w.y = cvt_pk_bf16(v0[2], v0[3]); w.z = cvt_pk_bf16(v1[0], v1[1]); w.w = cvt_pk_bf16(v1[2], v1[3]);
                    *(u32x4*)(rowp + bj * HALF) = w; } }
    }
};
struct EpiResid {
    static constexpr bool PERM = false, AFTER_DRAIN = false;
    bf16_t* xb; float* ssq; PG8_LAS float* P;
    __device__ __forceinline__ void operator()(const f32x4 (&acc)[2][2][4][2], const Unit& u, int wr, int wc, int fr, int fq, int) const {
        const int col0 = u.pn * BM + wc * 32 + 4 * fq;
#pragma unroll
        for (int ai = 0; ai < 2; ++ai)
#pragma unroll
            for (int m = 0; m < 4; ++m) { const int r = ai * HALF + wr * 64 + m * 16 + fr; const size_t off = (size_t)(u.pm * BM + r) * 1024 + col0; float s = 0.f;
#pragma unroll
                for (int bj = 0; bj < 2; ++bj)
#pragma unroll
                    for (int n = 0; n < 2; ++n) { const u32x2 bw = *(const u32x2*)(xb + off + bj * HALF + n * 16);
                        const f32x4 b = {__builtin_bit_cast(float, bw.x << 16), __builtin_bit_cast(float, bw.x & 0xffff0000u), __builtin_bit_cast(float, bw.y << 16), __builtin_bit_cast(float, bw.y & 0xffff0000u)};
                        const f32x4 v = b + acc[ai][bj][m][n];
                        u32x2 w; w.x = cvt_pk_bf16(v[0], v[1]); w.y = cvt_pk_bf16(v[2], v[3]); *(u32x2*)(xb + off + bj * HALF + n * 16) = w;
                        s += (v[0] * v[0] + v[1] * v[1]) + (v[2] * v[2] + v[3] * v[3]); }
                s += shx(s, 16, fr + 16 * fq); s += shx(s, 32, fr + 16 * fq);
                if (fq == 0) P[r * 4 + wc] = s;
                if (m == 3) asm volatile("" ::: "memory"); }
        asm volatile("s_waitcnt lgkmcnt(0)\n\ts_barrier" ::: "memory");
        int tid = threadIdx.x; asm volatile("" : "+v"(tid));
        if (tid < 256) { const f32x4 p = *(const PG8_LAS f32x4*)(P + tid * 4); ssq[(size_t)(u.pm * BM + tid) * 4 + u.pn] = (p[0] + p[1]) + (p[2] + p[3]); }
        asm volatile("s_waitcnt lgkmcnt(0)" ::: "memory");
    }
};
template <class Epi, class Sched, bool ALIGN_EPI = false, bool SP2 = false>
__device__ __forceinline__ void gemm_phase(PG8_LAS unsigned char* lds, const Gemm g, const Sched& S, const Epi& E) {
    int tid_ = threadIdx.x; asm volatile("" : "+v"(tid_));
    const int tid = tid_, wid = __builtin_amdgcn_readfirstlane(tid >> 6), lane = tid & 63, wr = wid >> 2, wc = wid & 3, fr = lane & 15, fq = lane >> 4;
    const int K = g.K, nt = K / BK;
    unsigned voffA[2], voffB[2];
#pragma unroll
    for (int i = 0; i < 2; ++i) { int R, C; stage_rc(tid * 16 + i * 8192, R, C); const int Rb = Epi::PERM ? ((R & ~31) + perm32(R & 31)) : R;
        voffA[i] = (unsigned)(R * K + C) * 2u; voffB[i] = (unsigned)(Rb * K + C) * 2u; }
    const size_t kstep = (size_t)(BK * 2);
    const size_t hstep = (size_t)HALF * K * 2;
    const size_t tstep = 2 * hstep;
    const unsigned ldsw = (unsigned)wid * 1024u;
    const int aoff = lds_byte(wr * 64 + fr, fq * 8), boff = lds_byte(wc * 32 + fr, fq * 8);
#define PG8_SA(b, h) (((b) * 2 + (h)) * HTB)
#define PG8_SB(b, h) ((4 + (b) * 2 + (h)) * HTB)
#define PG8_STAGE(bufoff, gbase, voff) do { _Pragma("unroll") for (int _i = 0; _i < 2; ++_i) \
        __builtin_amdgcn_global_load_lds((const unsigned*)((const char*)(gbase) + (voff)[_i]), (PG8_LAS unsigned*)(lds + (bufoff) + ldsw + _i * 8192), 16, 0, 0); } while (0)
#define PG8_LDA(dst, b, h) do { _Pragma("unroll") for (int m = 0; m < 4; ++m) _Pragma("unroll") for (int k = 0; k < 2; ++k) dst[m][k] = *(const PG8_LAS bf16x8*)(lds + PG8_SA(b, h) + aoff + m * 2048 + k * 1024); } while (0)
#define PG8_LDB(dst, b, h) do { _Pragma("unroll") for (int n = 0; n < 2; ++n) _Pragma("unroll") for (int k = 0; k < 2; ++k) dst[n][k] = *(const PG8_LAS bf16x8*)(lds + PG8_SB(b, h) + boff + n * 2048 + k * 1024); } while (0)
#define PG8_MMA(ai, bj, At, Bt) do { __builtin_amdgcn_s_setprio(1); _Pragma("unroll") for (int m = 0; m < 4; ++m) _Pragma("unroll") for (int n = 0; n < 2; ++n) _Pragma("unroll") for (int k = 0; k < 2; ++k) \
        acc[ai][bj][m][n] = __builtin_amdgcn_mfma_f32_16x16x32_bf16(Bt[n][k], At[m][k], acc[ai][bj][m][n], 0, 0, 0); __builtin_amdgcn_s_setprio(0); } while (0)
#define PG8_WAIT_V(n) asm volatile("s_waitcnt vmcnt(" #n ")" ::: "memory")
#define PG8_WAIT_L(n) asm volatile("s_waitcnt lgkmcnt(" #n ")" ::: "memory")
#define PG8_BAR __builtin_amdgcn_s_barrier()
#define PG8_SCHED __builtin_amdgcn_sched_barrier(0)
    Unit cur, nxt; int ui = 0;
    if (!S.next(0, cur)) return;
    f32x4 acc[2][2][4][2];
#pragma unroll
    for (int a = 0; a < 2; ++a)
#pragma unroll
        for (int b = 0; b < 2; ++b)
#pragma unroll
            for (int m = 0; m < 4; ++m)
#pragma unroll
                for (int n = 0; n < 2; ++n) acc[a][b][m][n] = (f32x4){0.f, 0.f, 0.f, 0.f};
    bf16x8 At[4][2], B0[2][2], B1[2][2];
    const char* cA = (const char*)g.A + (size_t)cur.pm * tstep; const char* cB = (const char*)g.Bt + (size_t)cur.pn * tstep;
    S.a_ready(cur);
    if constexpr (SP2) {
        PG8_STAGE(PG8_SB(0, 0), cB, voffB); PG8_STAGE(PG8_SB(0, 1), cB + hstep, voffB); PG8_STAGE(PG8_SA(0, 0), cA, voffA); PG8_STAGE(PG8_SA(0, 1), cA + hstep, voffA);
        if (wr == 1) PG8_BAR;
        PG8_WAIT_V(2); PG8_BAR;
        PG8_STAGE(PG8_SB(1, 0), cB + kstep, voffB); PG8_STAGE(PG8_SA(1, 0), cA + kstep, voffA); PG8_STAGE(PG8_SB(1, 1), cB + hstep + kstep, voffB);
        PG8_WAIT_V(6); PG8_BAR;
    } else {
        PG8_STAGE(PG8_SB(0, 0), cB, voffB); PG8_STAGE(PG8_SA(0, 0), cA, voffA); PG8_STAGE(PG8_SB(0, 1), cB + hstep, voffB); PG8_STAGE(PG8_SA(0, 1), cA + hstep, voffA);
        if (wr == 1) PG8_BAR;
        PG8_WAIT_V(4); PG8_BAR;
        PG8_STAGE(PG8_SB(1, 0), cB + kstep, voffB); PG8_STAGE(PG8_SA(1, 0), cA + kstep, voffA); PG8_STAGE(PG8_SB(1, 1), cB + hstep + kstep, voffB);
        PG8_WAIT_V(6); PG8_BAR;
    }
    for (;;) {
        const bool has_next = S.next(ui + 1, nxt);
        const char* nA = has_next ? (const char*)g.A + (size_t)nxt.pm * tstep : cA; const char* nB = has_next ? (const char*)g.Bt + (size_t)nxt.pn * tstep : cB;
        for (int t = 0; t < nt; t += 2) {
            const bool last = (t == nt - 2);
            const char* a1 = cA + (size_t)(t + 1) * kstep;
            const char* a2 = last ? nA : cA + (size_t)(t + 2) * kstep; const char* b2 = last ? nB : cB + (size_t)(t + 2) * kstep;
            const char* a3 = a2 + kstep; const char* b3 = b2 + kstep;
            if (last && has_next) S.a_ready(nxt);
            if constexpr (SP2) {
            PG8_LDB(B0, 0, 0); PG8_LDB(B1, 0, 1); PG8_SCHED; PG8_LDA(At, 0, 0); PG8_STAGE(PG8_SA(1, 1), a1 + hstep, voffA);
            PG8_WAIT_V(8); PG8_WAIT_L(0); PG8_BAR; PG8_MMA(0, 0, At, B0); PG8_MMA(0, 1, At, B1); PG8_BAR; PG8_SCHED;
            PG8_LDA(At, 0, 1); PG8_STAGE(PG8_SB(0, 0), b2, voffB); PG8_STAGE(PG8_SB(0, 1), b2 + hstep, voffB); PG8_STAGE(PG8_SA(0, 0), a2, voffA);
            PG8_WAIT_V(8); PG8_WAIT_L(0); PG8_BAR; PG8_MMA(1, 0, At, B0); PG8_MMA(1, 1, At, B1); PG8_BAR; PG8_SCHED;
            PG8_LDB(B0, 1, 0); PG8_LDB(B1, 1, 1); PG8_SCHED; PG8_LDA(At, 1, 0); PG8_STAGE(PG8_SA(0, 1), a2 + hstep, voffA);
            PG8_WAIT_V(8); PG8_WAIT_L(0); PG8_BAR; PG8_MMA(0, 0, At, B0); PG8_MMA(0, 1, At, B1); PG8_BAR; PG8_SCHED;
            PG8_LDA(At, 1, 1); PG8_STAGE(PG8_SB(1, 0), b3, voffB); PG8_STAGE(PG8_SB(1, 1), b3 + hstep, voffB); PG8_STAGE(PG8_SA(1, 0), a3, voffA);
            PG8_WAIT_V(8); PG8_WAIT_L(0); PG8_BAR; PG8_MMA(1, 0, At, B0); PG8_MMA(1, 1, At, B1); PG8_BAR; PG8_SCHED;
            } else {
            PG8_LDB(B0, 0, 0); PG8_SCHED; PG8_LDA(At, 0, 0); PG8_STAGE(PG8_SA(1, 1), a1 + hstep, voffA);
            PG8_WAIT_L(8); PG8_BAR; PG8_WAIT_L(0); PG8_MMA(0, 0, At, B0); PG8_BAR; PG8_SCHED;
            PG8_LDB(B1, 0, 1); PG8_STAGE(PG8_SB(0, 0), b2, voffB);
            PG8_BAR; PG8_WAIT_L(0); PG8_MMA(0, 1, At, B1); PG8_BAR;
            PG8_LDA(At, 0, 1); PG8_STAGE(PG8_SA(0, 0), a2, voffA);
            PG8_BAR; PG8_WAIT_L(0); PG8_MMA(1, 0, At, B0); PG8_BAR; PG8_SCHED;
            PG8_STAGE(PG8_SB(0, 1), b2 + hstep, voffB);
            PG8_WAIT_V(6); PG8_BAR; PG8_MMA(1, 1, At, B1); PG8_BAR;
            PG8_LDB(B0, 1, 0); PG8_SCHED; PG8_LDA(At, 1, 0); PG8_STAGE(PG8_SA(0, 1), a2 + hstep, voffA);
            PG8_WAIT_L(8); PG8_BAR; PG8_WAIT_L(0); PG8_MMA(0, 0, At, B0); PG8_BAR; PG8_SCHED;
            PG8_LDB(B1, 1, 1); PG8_STAGE(PG8_SB(1, 0), b3, voffB);
            PG8_BAR; PG8_WAIT_L(0); PG8_MMA(0, 1, At, B1); PG8_BAR;
            PG8_LDA(At, 1, 1); PG8_STAGE(PG8_SA(1, 0), a3, voffA);
            PG8_BAR; PG8_WAIT_L(0); PG8_MMA(1, 0, At, B0); PG8_BAR; PG8_SCHED;
            PG8_STAGE(PG8_SB(1, 1), b3 + hstep, voffB);
            PG8_WAIT_V(6); PG8_BAR; PG8_MMA(1, 1, At, B1); PG8_BAR;
            }
        }
        if constexpr (ALIGN_EPI) { if (wr == 0) PG8_BAR; }
        if constexpr (!Epi::AFTER_DRAIN) { E(acc, cur, wr, wc, fr, fq, ui); S.done(cur); }
        if (!has_next) break;
#pragma unroll
        for (int a = 0; a < 2; ++a)
#pragma unroll
            for (int b = 0; b < 2; ++b)
#pragma unroll
                for (int m = 0; m < 4; ++m)
#pragma unroll
                    for (int n = 0; n < 2; ++n) acc[a][b][m][n] = (f32x4){0.f, 0.f, 0.f, 0.f};
        cur = nxt; cA = nA; cB = nB; ++ui;
        if constexpr (ALIGN_EPI) { if (wr == 1) PG8_BAR; }
    }
    PG8_WAIT_V(0);
    if constexpr (!ALIGN_EPI) { if (wr == 0) PG8_BAR; }
    PG8_BAR;
    if constexpr (Epi::AFTER_DRAIN) { E.fused(acc, cur, wr, wc, fr, fq, lds, wid, lane); S.done(cur); }
#undef PG8_SA
#undef PG8_SB
#undef PG8_STAGE
#undef PG8_LDA
#undef PG8_LDB
#undef PG8_MMA
#undef PG8_WAIT_V
#undef PG8_WAIT_L
#undef PG8_BAR
#undef PG8_SCHED
}
}
#include <hip/hip_bf16.h>
#include <cmath>
namespace attn_body {
using bf16=__hip_bfloat16;
using bf16x8=__attribute__((ext_vector_type(8)))short;
using s16x4=__attribute__((ext_vector_type(4)))short;
using f32x16=__attribute__((ext_vector_type(16)))float;
using u32x4=__attribute__((ext_vector_type(4)))unsigned;
constexpr int BATCH=2,SEQ=16384,D=64,ZP=3072,OP=1024;
constexpr int NW=8,QBLK=32,QB=QBLK*NW,KVBLK=64,NQB=SEQ/QB;
constexpr int ATTN_UNIT_ROWS=QB;
__device__ __forceinline__ int crow(int r,int hi){return (r&3)+8*(r>>2)+4*hi;}
#define SBAR() __builtin_amdgcn_sched_barrier(0)
__device__ __forceinline__ void cmask(f32x16&p0,f32x16&p1,int jb,int qrel,int hi){
  const float NEG=-INFINITY; int kb=64*jb+4*hi;
  #pragma unroll
  for(int r=0;r<16;++r){int kv=kb+(r&3)+8*(r>>2); if(kv>qrel)p0[r]=NEG; if(kv+32>qrel)p1[r]=NEG;}
}

constexpr int NSLOT=3, SLOTB=8192;
constexpr int LDS_K=0, LDS_V=NSLOT*SLOTB, LDS_WS=2*NSLOT*SLOTB, LDS_OST=LDS_WS+NW*64*4, LDS_BYTES=LDS_OST+NW*4096;
constexpr int LDS_EXTRA=LDS_BYTES, LDS_CS=LDS_EXTRA  , LDS_OST2=LDS_EXTRA  , LDS_TBL=LDS_EXTRA+NW*4096  , LDS_AUX=LDS_EXTRA+65536, LDS_TOTAL=LDS_AUX+256;
typedef __attribute__((address_space(3))) float ldsf; typedef __attribute__((address_space(3))) const float cldsf; typedef float f32x4a __attribute__((ext_vector_type(4)));
constexpr float LOG2E=1.4426950408889634f;
constexpr float C2=0.125f*1.4426950408889634f;
__device__ __forceinline__ void glds16(const void*gsrc,unsigned lds_dst){unsigned keep;
  asm volatile("s_mov_b32 %0, m0\n\ts_mov_b32 m0, %2\n\ts_nop 0\n\tglobal_load_lds_dwordx4 %1, off\n\ts_mov_b32 m0, %0":"=&s"(keep):"v"(gsrc),"s"(lds_dst):"memory");}
__device__ __forceinline__ void glds16s(const void*sbase,unsigned voff,unsigned lds_dst){unsigned keep;
  asm volatile("s_mov_b32 %0, m0\n\ts_mov_b32 m0, %3\n\ts_nop 0\n\tglobal_load_lds_dwordx4 %1, %2\n\ts_mov_b32 m0, %0":"=&s"(keep):"v"(voff),"s"(sbase),"s"(lds_dst):"memory");}
__device__ __forceinline__ void glds16s3(const void*kbase,unsigned koff,unsigned kdst,const void*vbase,unsigned voff,unsigned vdst){unsigned keep;
  asm volatile("s_mov_b32 %0, m0\n\ts_mov_b32 m0, %3\n\ts_nop 0\n\tglobal_load_lds_dwordx4 %1, %2\n\t"
               "s_mov_b32 m0, %6\n\ts_nop 0\n\tglobal_load_lds_dwordx4 %4, %5\n\t"
               "s_mov_b32 m0, %7\n\ts_nop 0\n\tglobal_load_lds_dwordx4 %4, %5 offset:128\n\ts_mov_b32 m0, %0"
               :"=&s"(keep):"v"(koff),"s"(kbase),"s"(kdst),"v"(voff),"s"(vbase),"s"(vdst),"s"(vdst+8192u-128u):"memory");}
__device__ __forceinline__ float max3f(float a,float b,float c){float r;asm("v_max3_f32 %0, %1, %2, %3":"=v"(r):"v"(a),"v"(b),"v"(c));return r;}
__device__ __forceinline__ float max2f(float a,float b){float r;asm("v_max_f32_e32 %0, %1, %2":"=v"(r):"v"(a),"v"(b));return r;}
__device__ __forceinline__ float fadd_s(float a,float b){float r;asm("v_add_f32_e32 %0, %1, %2":"=v"(r):"v"(a),"v"(b));return r;}
__device__ __forceinline__ float fsub_s(float a,float b){float r;asm("v_sub_f32_e32 %0, %1, %2":"=v"(r):"v"(a),"v"(b));return r;}
typedef float f32x2_t __attribute__((ext_vector_type(2))); typedef __bf16 bf16x2_t __attribute__((ext_vector_type(2)));
__device__ __forceinline__ unsigned cvtpk_s(float lo,float hi){f32x2_t v={lo,hi};bf16x2_t b=__builtin_convertvector(v,bf16x2_t);return __builtin_bit_cast(unsigned,b);}
#define WAIT_BAR(N) asm volatile("s_waitcnt vmcnt(" #N ") lgkmcnt(0)\n\ts_barrier":::"memory")

__device__ __forceinline__ void qkt(f32x16&p0,f32x16&p1,const char*Kslot,const bf16x8*qr,const f32x16&negm,int r32,int hi){
  const char*kb=Kslot+hi*1024+r32*16;
  #pragma unroll
  for(int d0=0;d0<4;++d0){
    const bf16x8 b0=*reinterpret_cast<const bf16x8*>(kb+d0*2048);
    const bf16x8 b1=*reinterpret_cast<const bf16x8*>(kb+d0*2048+512);
    if(d0==0){p0=__builtin_amdgcn_mfma_f32_32x32x16_bf16(b0,qr[0],negm,0,0,0);p1=__builtin_amdgcn_mfma_f32_32x32x16_bf16(b1,qr[0],negm,0,0,0);}
    else{p0=__builtin_amdgcn_mfma_f32_32x32x16_bf16(b0,qr[d0],p0,0,0,0);p1=__builtin_amdgcn_mfma_f32_32x32x16_bf16(b1,qr[d0],p1,0,0,0);}}
}
typedef __attribute__((address_space(3))) const char* lds_cptr;
typedef short v4i16_t __attribute__((ext_vector_type(4)));
__device__ __forceinline__ void kload8(bf16x8*kf,lds_cptr kp){
  kf[0]=*(const __attribute__((address_space(3))) bf16x8*)(kp);      kf[1]=*(const __attribute__((address_space(3))) bf16x8*)(kp+512);
  kf[2]=*(const __attribute__((address_space(3))) bf16x8*)(kp+2048); kf[3]=*(const __attribute__((address_space(3))) bf16x8*)(kp+2560);
  kf[4]=*(const __attribute__((address_space(3))) bf16x8*)(kp+4096); kf[5]=*(const __attribute__((address_space(3))) bf16x8*)(kp+4608);
  kf[6]=*(const __attribute__((address_space(3))) bf16x8*)(kp+6144); kf[7]=*(const __attribute__((address_space(3))) bf16x8*)(kp+6656);
}
__device__ __forceinline__ void kload2(bf16x8*kf,lds_cptr kp,int j){ kf[2*j]=*(const __attribute__((address_space(3))) bf16x8*)(kp+j*2048); kf[2*j+1]=*(const __attribute__((address_space(3))) bf16x8*)(kp+j*2048+512); }
__device__ __forceinline__ s16x4 vtr(lds_cptr p){ return __builtin_bit_cast(s16x4,__builtin_amdgcn_ds_read_tr16_b64_v4i16((__attribute__((address_space(3))) v4i16_t*)p)); }
__device__ __forceinline__ float rowmax(const f32x16&p0,const f32x16&p1){
  float a=max3f(p0[0],p0[1],p1[0]),b=max3f(p0[2],p0[3],p1[1]);a=max3f(a,p1[2],p1[3]);
  #pragma unroll
  for(int r=4;r<16;r+=4){a=max3f(a,p0[r],p0[r+1]);b=max3f(b,p0[r+2],p0[r+3]);a=max3f(a,p1[r],p1[r+1]);b=max3f(b,p1[r+2],p1[r+3]);}
  const float m=max2f(a,b);
  auto rr=__builtin_amdgcn_permlane32_swap(__float_as_uint(m),__float_as_uint(m),false,false);
  return max2f(__uint_as_float(rr[0]),__uint_as_float(rr[1]));
}
__device__ __forceinline__ void pv(f32x16*o,int vb,bf16x8 pa0,bf16x8 pa1,bf16x8 pa2,bf16x8 pa3){
  #pragma unroll
  for(int d0=0;d0<2;++d0){s16x4 lo[4],hi[4];
    #pragma unroll
    for(int ks=0;ks<4;++ks){
      asm volatile("ds_read_b64_tr_b16 %0,%1 offset:%c2":"=&v"(lo[ks]):"v"(vb),"i"(d0*4096+ks*1024):"memory");
      asm volatile("ds_read_b64_tr_b16 %0,%1 offset:%c2":"=&v"(hi[ks]):"v"(vb),"i"(d0*4096+ks*1024+512):"memory");}
    asm volatile("s_waitcnt lgkmcnt(0)":::"memory");SBAR();
    #define PK(k) (bf16x8){lo[k][0],lo[k][1],lo[k][2],lo[k][3],hi[k][0],hi[k][1],hi[k][2],hi[k][3]}
    o[d0]=__builtin_amdgcn_mfma_f32_32x32x16_bf16(pa0,PK(0),o[d0],0,0,0);
    o[d0]=__builtin_amdgcn_mfma_f32_32x32x16_bf16(pa1,PK(1),o[d0],0,0,0);
    o[d0]=__builtin_amdgcn_mfma_f32_32x32x16_bf16(pa2,PK(2),o[d0],0,0,0);
    o[d0]=__builtin_amdgcn_mfma_f32_32x32x16_bf16(pa3,PK(3),o[d0],0,0,0);
    #undef PK
  }
}


__device__ __forceinline__ void subcs(f32x16&p0,f32x16&p1,cldsf*c,float mh){
  #pragma unroll
  for(int g=0;g<4;++g){ const f32x4a a=*(const __attribute__((address_space(3))) f32x4a*)(c+8*g)+mh, b4=*(const __attribute__((address_space(3))) f32x4a*)(c+32+8*g)+mh;
    #pragma unroll
    for(int i=0;i<4;++i){p0[4*g+i]-=a[i];p1[4*g+i]-=b4[i];}
    if(g==1)SBAR(); }
}
__device__ __forceinline__ void submh(f32x16&p0,f32x16&p1,float mh){
  #pragma unroll
  for(int r=0;r<16;++r){p0[r]-=mh;p1[r]-=mh;}
}
__device__ __forceinline__ void dbias(f32x16&p0,f32x16&p1,int jb,int wid,int r32,int hi,cldsf*tbl){
  if(jb>(wid>>1)){
    #pragma unroll
    for(int r=0;r<16;++r){p0[r]=-INFINITY;p1[r]=-INFINITY;}
  } else {
    cldsf*tp=tbl+(447+64*jb-(32*wid+r32)+4*hi);
    #pragma unroll
    for(int g=0;g<4;++g){
      #pragma unroll
      for(int i=0;i<4;++i){p0[4*g+i]+=tp[8*g+i];p1[4*g+i]+=tp[32+8*g+i];}}
  }
}
#ifndef ATTN_STORE16
#define ATTN_STORE16(p,v) (*(u32x4*)(p)=(v))
#endif
template<int MODE,int THRL,bool NOMAX> __device__ __forceinline__ void attn_unit(int qb,int kt0,const bf16*Qh,const bf16*__restrict__ Kh0,const bf16*__restrict__ Vh0,bf16*Oh,char*shm,int EPI,int stgoff,float lam){
  const bf16*Kh=Kh0+(long)kt0*KVBLK*ZP,*Vh=Vh0+(long)kt0*KVBLK*ZP;
  int tid_=threadIdx.x; asm volatile("":"+v"(tid_)); const int tid=tid_,lane=tid&63,r32=lane&31,hi=lane>>5; const int wid=__builtin_amdgcn_readfirstlane(tid>>6);
  const int q0=qb*QB;
  const bf16*Qw=Qh+(long)(q0+wid*QBLK)*ZP;
  cldsf*csl=(cldsf*)(lds_cptr)shm+LDS_CS/4+64*kt0; cldsf*tbl=(cldsf*)(lds_cptr)shm+LDS_TBL/4; (void)csl;(void)tbl;
  const unsigned lds0=(unsigned)(uintptr_t)shm;
  float*wsf=(float*)(shm+LDS_WS)+wid*64;
  const unsigned koff=(unsigned)(lane*ZP+wid*8)*2u;
  const unsigned voff=(unsigned)((16*(wid&3)+(lane>>2))*ZP+(wid>>2)*32+(lane&3)*8)*2u;
  const unsigned kdst=lds0+LDS_K+wid*1024, vdst=lds0+LDS_V+wid*1024;
  #define DMA_K(t,slot) glds16s(Kh+(long)(t)*KVBLK*ZP,koff,(unsigned)__builtin_amdgcn_readfirstlane(kdst+(slot)))
  #define DMA_V(t,slot) glds16s(Vh+(long)(t)*KVBLK*ZP,voff,(unsigned)__builtin_amdgcn_readfirstlane(vdst+(slot)))
  const int vb0=(int)(lds0+LDS_V)+((lane>>4)&1)*32+(lane&3)*8+(4*hi+((lane&15)>>2))*64;
  const char*Kbase=shm+LDS_K; bf16x8 kf[8];
  const lds_cptr shm3=(lds_cptr)shm; const lds_cptr kp0=shm3+LDS_K+hi*1024+r32*16; const lds_cptr vp0=shm3+LDS_V+((lane>>4)&1)*32+(lane&3)*8+(4*hi+((lane&15)>>2))*64;
  const int NT=(q0+QB)/KVBLK-kt0;
  DMA_K(0,0);DMA_V(0,0);DMA_K(1,SLOTB);
  bf16x8 qr[4];
  #pragma unroll
  for(int d0=0;d0<4;++d0)qr[d0]=*reinterpret_cast<const bf16x8*>(&Qw[(long)r32*ZP+d0*16+hi*8]);
  float mhat=0.f,l_reg=0.f;f32x16 o[2];o[0]=f32x16{};o[1]=f32x16{};f32x16 negm=f32x16{}; if(MODE==1){asm volatile("":"+v"(negm));}
  if(NOMAX){ mhat=-((cldsf*)(lds_cptr)shm+LDS_CS/4)[q0+wid*QBLK+r32]; }
  const int qrel=wid*QBLK+r32;
  #define CMASK(P0,P1,t) do{ const int jb_=(t)-(NT-4); if(MODE==0){ subcs(P0,P1,csl+64*(t)+4*hi,mhat); if(jb_>=0)cmask(P0,P1,jb_,qrel,hi); } else { if(jb_>=-3)dbias(P0,P1,jb_,wid,r32,hi,tbl); } }while(0)
  bool resc=false;
  #define START(P0,P1) do{ resc=false; if(!NOMAX) \
    { const float rm=rowmax(P0,P1); const float dl=rm; mhat=fadd_s(mhat,dl); \
      _Pragma("unroll") for(int r=0;r<16;++r){P0[r]=fsub_s(P0[r],dl);P1[r]=fsub_s(P1[r],dl);} \
      if(MODE==1){ _Pragma("unroll") for(int r=0;r<16;++r)negm[r]=-mhat; asm volatile("":"+v"(negm)); } } \
    _Pragma("unroll") for(int r=0;r<16;++r)P0[r]=__builtin_amdgcn_exp2f(P0[r]); }while(0)
  #define RESC() do{ if(resc){ asm volatile("s_waitcnt lgkmcnt(0)":::"memory"); \
      _Pragma("unroll") for(int d_=0;d_<2;++d_) _Pragma("unroll") for(int r=0;r<16;++r)o[d_][r]*=wsf[crow(r,hi)]; } }while(0)
  f32x16 pA0,pA1,pB0,pB1;
  int sl_prev=0,sl_cur=0,sl_next=SLOTB;
  #define ROT() do{sl_prev=sl_cur;sl_cur=sl_next;sl_next=(sl_next==(NSLOT-1)*SLOTB)?0:sl_next+SLOTB;}while(0)
  DMA_K(2,2*SLOTB);
  WAIT_BAR(3);
  qkt(pA0,pA1,Kbase,qr,negm,r32,hi);asm volatile("s_nop 15\n\ts_nop 7":"+v"(pA0),"+v"(pA1));CMASK(pA0,pA1,0);
  START(pA0,pA1);
  _Pragma("unroll") for(int r=0;r<16;++r)pA1[r]=__builtin_amdgcn_exp2f(pA1[r]);
  WAIT_BAR(0);
  DMA_K(3,0);DMA_V(1,SLOTB);
  ROT();
  kload8(kf,kp0+sl_cur);
  WAIT_BAR(2);
  s16x4 vlo[8],vhi[8]; u32x4 pw0,pw1,pw2,pw3;
  #define PKW(P,B) cvtpk_s(P[B],P[B+1])
  #define PAF(k) __builtin_bit_cast(bf16x8,pw##k)
  #define VFR(i) (bf16x8){vlo[i][0],vlo[i][1],vlo[i][2],vlo[i][3],vhi[i][0],vhi[i][1],vhi[i][2],vhi[i][3]}
  #define PIN(x) asm volatile("":"+v"(x))
  #define MX3(a,b,c) __builtin_fmaxf(__builtin_fmaxf((a),(b)),(c))
  #define GAPA(MF,A0,A1,A2,A3,W0,W1,PW) do{ MF; sacc+=A0; sacc+=A1; sacc+=A2; sacc+=A3; PIN(sacc); W0; W1; PIN(PW); SBAR(); }while(0)
  #define EX(v) __builtin_amdgcn_exp2f(v)
  #define GAPB(MF,X,B) do{ MF; X[B]=EX(X[B]); X[B+1]=EX(X[B+1]); X[B+2]=EX(X[B+2]); X[B+3]=EX(X[B+3]); PIN(X); SBAR(); }while(0)
  #define VRD(i) do{ vlo[i]=vtr(vp_+(((i)>>2)*4096+((i)&3)*1024)); vhi[i]=vtr(vp_+(((i)>>2)*4096+((i)&3)*1024+512)); }while(0)
  #define KRD(G,j) do{ if(G){ kload2(kf,kp0+sl_next,j); SBAR(); } }while(0)
  #define STEP(C0,C1,P0,P1,t,GK,GV,GL) do{ SBAR(); \
    const lds_cptr vp_=vp0+sl_prev; \
    VRD(0); SBAR(); float sacc=(P0[0]+P0[1]); \
    GAPA(C0=__builtin_amdgcn_mfma_f32_32x32x16_bf16(kf[0],qr[0],negm,0,0,0), P0[2],P0[3],P0[4],P0[5],     pw0[0]=PKW(P0,0), pw0[1]=PKW(P0,2), pw0); \
    VRD(4); SBAR(); GAPA(C1=__builtin_amdgcn_mfma_f32_32x32x16_bf16(kf[1],qr[0],negm,0,0,0), P0[6],P0[7],P0[8],P0[9],     pw0[2]=PKW(P0,4), pw0[3]=PKW(P0,6), pw0); \
    VRD(1); SBAR(); GAPA(C0=__builtin_amdgcn_mfma_f32_32x32x16_bf16(kf[2],qr[1],C0,0,0,0),   P0[10],P0[11],P0[12],P0[13], pw1[0]=PKW(P0,8), pw1[1]=PKW(P0,10), pw1); \
    VRD(5); SBAR(); GAPA(C1=__builtin_amdgcn_mfma_f32_32x32x16_bf16(kf[3],qr[1],C1,0,0,0),   P0[14],P0[15],P1[0],P1[1],   pw1[2]=PKW(P0,12),pw1[3]=PKW(P0,14), pw1); \
    VRD(2); SBAR(); GAPA(C0=__builtin_amdgcn_mfma_f32_32x32x16_bf16(kf[4],qr[2],C0,0,0,0),   P1[2],P1[3],P1[4],P1[5],     pw2[0]=PKW(P1,0), pw2[1]=PKW(P1,2), pw2); \
    VRD(6); SBAR(); GAPA(C1=__builtin_amdgcn_mfma_f32_32x32x16_bf16(kf[5],qr[2],C1,0,0,0),   P1[6],P1[7],P1[8],P1[9],     pw2[2]=PKW(P1,4), pw2[3]=PKW(P1,6), pw2); \
    VRD(3); SBAR(); GAPA(C0=__builtin_amdgcn_mfma_f32_32x32x16_bf16(kf[6],qr[3],C0,0,0,0),   P1[10],P1[11],P1[12],P1[13], pw3[0]=PKW(P1,8), pw3[1]=PKW(P1,10), pw3); \
    VRD(7); SBAR(); GAPA(C1=__builtin_amdgcn_mfma_f32_32x32x16_bf16(kf[7],qr[3],C1,0,0,0),   P1[14],P1[15],0.f,0.f,       pw3[2]=PKW(P1,12),pw3[3]=PKW(P1,14), pw3); \
    l_reg+=sacc; \
    if(GK){DMA_K((t)+3,sl_cur);} if(GV){DMA_V((t)+1,sl_next);} \
    CMASK(C0,C1,t); \
    if(!NOMAX){ float a=MX3(C0[0],C0[1],C1[0]),b=MX3(C0[2],C0[3],C1[1]); a=MX3(a,C1[2],C1[3]); \
      _Pragma("unroll") for(int r=4;r<16;r+=4){a=MX3(a,C0[r],C0[r+1]);b=MX3(b,C0[r+2],C0[r+3]);a=MX3(a,C1[r],C1[r+1]);b=MX3(b,C1[r+2],C1[r+3]);} \
      float rm=__builtin_fmaxf(a,b); { auto rr=__builtin_amdgcn_permlane32_swap(__float_as_uint(rm),__float_as_uint(rm),false,false); rm=__builtin_fmaxf(__uint_as_float(rr[0]),__uint_as_float(rr[1])); } \
      resc=false; \
      if(__builtin_expect(__any(rm>(float)THRL),0)){ const float dl=__builtin_fmaxf(rm,0.f); mhat+=dl; \
        _Pragma("unroll") for(int r=0;r<16;++r){C0[r]-=dl;C1[r]-=dl;} \
        if(MODE==1){ _Pragma("unroll") for(int r=0;r<16;++r)negm[r]=-mhat; asm volatile("":"+v"(negm)); } \
        const float f=__builtin_amdgcn_exp2f(-dl); l_reg*=f; if(hi==0)wsf[r32]=f; resc=true; } } \
    SBAR(); \
    GAPB(o[0]=__builtin_amdgcn_mfma_f32_32x32x16_bf16(PAF(0),VFR(0),o[0],0,0,0), C0,0); \
    GAPB(o[1]=__builtin_amdgcn_mfma_f32_32x32x16_bf16(PAF(0),VFR(4),o[1],0,0,0), C0,4); \
    KRD(GL,0); GAPB(o[0]=__builtin_amdgcn_mfma_f32_32x32x16_bf16(PAF(1),VFR(1),o[0],0,0,0), C0,8); \
    KRD(GL,1); GAPB(o[1]=__builtin_amdgcn_mfma_f32_32x32x16_bf16(PAF(1),VFR(5),o[1],0,0,0), C0,12); \
    KRD(GL,2); GAPB(o[0]=__builtin_amdgcn_mfma_f32_32x32x16_bf16(PAF(2),VFR(2),o[0],0,0,0), C1,0); \
    KRD(GL,3); GAPB(o[1]=__builtin_amdgcn_mfma_f32_32x32x16_bf16(PAF(2),VFR(6),o[1],0,0,0), C1,4); \
    GAPB(o[0]=__builtin_amdgcn_mfma_f32_32x32x16_bf16(PAF(3),VFR(3),o[0],0,0,0), C1,8); \
    GAPB(o[1]=__builtin_amdgcn_mfma_f32_32x32x16_bf16(PAF(3),VFR(7),o[1],0,0,0), C1,12); \
    }while(0)
  int t=1;
  #undef CMASK
  #define CMASK(P0,P1,t) do{ if(MODE==0){ subcs(P0,P1,csl+64*(t)+4*hi,mhat); } }while(0)
  for(;t+7<NT;t+=2){
    STEP(pB0,pB1,pA0,pA1,t,true,true,true);     WAIT_BAR(2); RESC(); ROT();
    STEP(pA0,pA1,pB0,pB1,t+1,true,true,true);   WAIT_BAR(2); RESC(); ROT();
  }
  #undef CMASK
  #define CMASK(P0,P1,t) do{ const int jb_=(t)-(NT-4); if(MODE==0){ subcs(P0,P1,csl+64*(t)+4*hi,mhat); if(jb_>=0)cmask(P0,P1,jb_,qrel,hi); } else { if(jb_>=-3)dbias(P0,P1,jb_,wid,r32,hi,tbl); } }while(0)
  #define ENDW(tt) do{ if((tt)+3<NT){WAIT_BAR(2);} else if((tt)+2<NT){WAIT_BAR(1);} else {WAIT_BAR(0);} }while(0)
  for(;t+1<NT;t+=2){
    STEP(pB0,pB1,pA0,pA1,t,(t+3<NT),(t+1<NT),(t+1<NT));       ENDW(t);   RESC(); ROT();
    STEP(pA0,pA1,pB0,pB1,t+1,(t+4<NT),(t+2<NT),(t+2<NT));     ENDW(t+1); RESC(); ROT();
  }
  STEP(pB0,pB1,pA0,pA1,NT-1,false,false,false); RESC();
  { float sacc=pB0[0]+pB0[1]; _Pragma("unroll") for(int r=2;r<16;++r)sacc+=pB0[r]; _Pragma("unroll") for(int r=0;r<16;++r)sacc+=pB1[r]; l_reg+=sacc;
    pw0=(u32x4){PKW(pB0,0),PKW(pB0,2),PKW(pB0,4),PKW(pB0,6)};pw1=(u32x4){PKW(pB0,8),PKW(pB0,10),PKW(pB0,12),PKW(pB0,14)};pw2=(u32x4){PKW(pB1,0),PKW(pB1,2),PKW(pB1,4),PKW(pB1,6)};pw3=(u32x4){PKW(pB1,8),PKW(pB1,10),PKW(pB1,12),PKW(pB1,14)};
    SBAR(); pv(o,vb0+sl_cur,PAF(0),PAF(1),PAF(2),PAF(3)); }
  #undef PKW
  #undef PAF
  #undef VFR
  #undef PIN
  #undef MX3
  #undef GAPA
  #undef GAPB
  #undef EX
  #undef VRD
  #undef KRD
  #undef STEP
  #undef ENDW
  {auto rr=__builtin_amdgcn_permlane32_swap(__float_as_uint(l_reg),__float_as_uint(l_reg),false,false);l_reg=__uint_as_float(rr[0])+__uint_as_float(rr[1]);}
  if(hi==0)wsf[32+r32]=l_reg;asm volatile("s_waitcnt lgkmcnt(0)":::"memory");
  float rli[16];
  #pragma unroll
  for(int r=0;r<16;++r)rli[r]=__builtin_amdgcn_rcpf(wsf[32+crow(r,hi)]);
  { bf16*stg=(bf16*)(shm+stgoff)+wid*2048;
    #pragma unroll
    for(int r=0;r<16;++r){const int orow=crow(r,hi);
      #pragma unroll
      for(int d0=0;d0<2;++d0){ float val=o[d0][r]*rli[r];
        if(EPI==2){ val=__bfloat162float(stg[orow*64+d0*32+r32])-lam*val; }
        stg[orow*64+d0*32+r32]=__float2bfloat16(val);}}
    asm volatile("s_waitcnt lgkmcnt(0)":::"memory");
    if(EPI==0){ bf16*Ow=Oh+(long)(q0+wid*QBLK)*OP;
      #pragma unroll
      for(int i=0;i<4;++i){const int row=i*8+(lane>>3),ch=lane&7; const u32x4 v=*(const u32x4*)(stg+row*64+ch*8); ATTN_STORE16(Ow+(long)row*OP+ch*8,v);} } }
  asm volatile("s_waitcnt lgkmcnt(0)\n\ts_barrier":::"memory");
  #undef DMA_K
  #undef DMA_V
  #undef CMASK
  #undef START
  #undef RESC
  #undef ROT
}
constexpr int D2_K=0, D2_V=NSLOT*SLOTB, D2_WS=D2_V+NSLOT*2*SLOTB, D2_OST=D2_WS+NW*64*4, D2_TBL=D2_OST+NW*8192, D2_END=D2_TBL+2048;
static_assert(D2_END<=LDS_AUX,"diff unit LDS map");
template<int THRL,bool NOMAX> __device__ __forceinline__ void attn_unit2(int qb,const bf16*Qh,const bf16*__restrict__ Kh,const bf16*__restrict__ Vh,char*shm,int EPI,float lam){
  constexpr int MODE=1;
  int tid_=threadIdx.x; asm volatile("":"+v"(tid_)); const int tid=tid_,lane=tid&63,r32=lane&31,hi=lane>>5; const int wid=__builtin_amdgcn_readfirstlane(tid>>6);
  const int q0=qb*QB;
  const bf16*Qw=Qh+(long)(q0+wid*QBLK)*ZP;
  cldsf*csl=nullptr; cldsf*tbl=(cldsf*)(lds_cptr)shm+D2_TBL/4; (void)csl;(void)tbl;
  const unsigned lds0=(unsigned)(uintptr_t)shm;
  float*wsf=(float*)(shm+D2_WS)+wid*64;
  const unsigned koff=(unsigned)(lane*ZP+wid*8)*2u;
  const unsigned voff=(unsigned)((16*(wid&3)+(lane>>2))*ZP+(wid>>2)*32+(lane&3)*8)*2u;
  const unsigned kdst=lds0+D2_K+wid*1024, vdst=lds0+D2_V+wid*1024;
  #define DMA_K(t,slot) glds16s(Kh+(long)(t)*KVBLK*ZP,koff,(unsigned)__builtin_amdgcn_readfirstlane(kdst+(slot)))
  #define DMA_V(t,slot) do{ glds16s(Vh+(long)(t)*KVBLK*ZP,voff,(unsigned)__builtin_amdgcn_readfirstlane(vdst+2*(slot))); glds16s(Vh+(long)(t)*KVBLK*ZP+64,voff,(unsigned)__builtin_amdgcn_readfirstlane(vdst+2*(slot)+8192)); }while(0)
  const int vb0=(int)(lds0+D2_V)+((lane>>4)&1)*32+(lane&3)*8+(4*hi+((lane&15)>>2))*64;
  const char*Kbase=shm+D2_K; bf16x8 kf[8];
  const lds_cptr shm3=(lds_cptr)shm; const lds_cptr kp0=shm3+D2_K+hi*1024+r32*16; const lds_cptr vp0=shm3+D2_V+((lane>>4)&1)*32+(lane&3)*8+(4*hi+((lane&15)>>2))*64;
  const int NT=(q0+QB)/KVBLK;
  DMA_K(0,0);DMA_V(0,0);DMA_K(1,SLOTB);
  bf16x8 qr[4];
  #pragma unroll
  for(int d0=0;d0<4;++d0)qr[d0]=*reinterpret_cast<const bf16x8*>(&Qw[(long)r32*ZP+d0*16+hi*8]);
  float mhat=0.f,l_reg=0.f;f32x16 o[4];o[0]=f32x16{};o[1]=f32x16{};o[2]=f32x16{};o[3]=f32x16{};
  const f32x16 zc=f32x16{};
  #define FIX(C0,C1,t) do{ const int jb_=(t)-(NT-4); submh(C0,C1,mhat); if(jb_>=-3)dbias(C0,C1,jb_,wid,r32,hi,tbl); }while(0)
  bool resc=false;
  #define RESC() do{ if(resc){ asm volatile("s_waitcnt lgkmcnt(0)":::"memory"); \
      _Pragma("unroll") for(int d_=0;d_<4;++d_) _Pragma("unroll") for(int r=0;r<16;++r)o[d_][r]*=wsf[crow(r,hi)]; } }while(0)
  f32x16 c0,c1;
  u32x4 pa0,pa1,pa2,pa3,pb0,pb1,pb2,pb3;
  int sl_prev=0,sl_cur=0,sl_next=SLOTB;
  #define ROT() do{sl_prev=sl_cur;sl_cur=sl_next;sl_next=(sl_next==(NSLOT-1)*SLOTB)?0:sl_next+SLOTB;}while(0)
  DMA_K(2,2*SLOTB);
  WAIT_BAR(3);
  #define EX(v) __builtin_amdgcn_exp2f(v)
  #define PKW(P,B) cvtpk_s(P[B],P[B+1])
  #define PIN(x) asm volatile("":"+v"(x))
  qkt(c0,c1,Kbase,qr,zc,r32,hi);asm volatile("s_nop 15\n\ts_nop 7":"+v"(c0),"+v"(c1));
  { const int jb_=0-(NT-4); if(jb_>=-3)dbias(c0,c1,jb_,wid,r32,hi,tbl); }
  { const float rm=NOMAX?0.f:rowmax(c0,c1); mhat=rm;
    _Pragma("unroll") for(int r=0;r<16;++r){c0[r]=EX(c0[r]-rm);c1[r]=EX(c1[r]-rm);}
    float sacc=0.f; _Pragma("unroll") for(int r=0;r<16;++r){sacc+=c0[r];} _Pragma("unroll") for(int r=0;r<16;++r){sacc+=c1[r];} l_reg=sacc;
    pa0=(u32x4){PKW(c0,0),PKW(c0,2),PKW(c0,4),PKW(c0,6)};pa1=(u32x4){PKW(c0,8),PKW(c0,10),PKW(c0,12),PKW(c0,14)};pa2=(u32x4){PKW(c1,0),PKW(c1,2),PKW(c1,4),PKW(c1,6)};pa3=(u32x4){PKW(c1,8),PKW(c1,10),PKW(c1,12),PKW(c1,14)}; }
  WAIT_BAR(0);
  DMA_K(3,0);DMA_V(1,SLOTB);
  ROT();
  kload8(kf,kp0+sl_cur);
  WAIT_BAR(3);
  s16x4 vlo[8],vhi[8];
  #define PAF(S,k) __builtin_bit_cast(bf16x8,S##k)
  #define VFR(i) (bf16x8){vlo[i][0],vlo[i][1],vlo[i][2],vlo[i][3],vhi[i][0],vhi[i][1],vhi[i][2],vhi[i][3]}
  #define MX3(a,b,c) __builtin_fmaxf(__builtin_fmaxf((a),(b)),(c))
  #define VRD(i) do{ vlo[i]=vtr(vp_+(((i)>>2)*4096+((i)&3)*1024)); vhi[i]=vtr(vp_+(((i)>>2)*4096+((i)&3)*1024+512)); }while(0)
  #define VRDB(i) do{ vlo[i]=vtr(vp_+(8192+((i)>>2)*4096+((i)&3)*1024)); vhi[i]=vtr(vp_+(8192+((i)>>2)*4096+((i)&3)*1024+512)); SBAR(); }while(0)
  #define KRD(G,j) do{ if(G){ kload2(kf,kp0+sl_next,j); SBAR(); } }while(0)
  #define GAPA(MF) do{ MF; SBAR(); }while(0)
  #define GAPB(MF,X,B,DV,DI) do{ MF; X[B]=EX(X[B]); X[B+1]=EX(X[B+1]); sacc+=X[B]; sacc+=X[B+1]; DV[DI]=cvtpk_s(X[B],X[B+1]); PIN(sacc); PIN(DV); SBAR(); }while(0)
  #define GAPB4(MF,X,B,DV,DI) do{ MF; X[B]=EX(X[B]); X[B+1]=EX(X[B+1]); X[B+2]=EX(X[B+2]); X[B+3]=EX(X[B+3]); sacc+=X[B]; sacc+=X[B+1]; sacc+=X[B+2]; sacc+=X[B+3]; DV[DI]=cvtpk_s(X[B],X[B+1]); DV[DI+1]=cvtpk_s(X[B+2],X[B+3]); PIN(sacc); PIN(DV); SBAR(); }while(0)
  #define STEP(SP,SN,t,GK,GV,GL) do{ SBAR(); \
    const lds_cptr vp_=vp0+2*sl_prev; \
    VRD(0); SBAR(); GAPA(c0=__builtin_amdgcn_mfma_f32_32x32x16_bf16(kf[0],qr[0],zc,0,0,0)); \
    VRD(4); SBAR(); GAPA(c1=__builtin_amdgcn_mfma_f32_32x32x16_bf16(kf[1],qr[0],zc,0,0,0)); \
    VRD(1); SBAR(); GAPA(c0=__builtin_amdgcn_mfma_f32_32x32x16_bf16(kf[2],qr[1],c0,0,0,0)); \
    VRD(5); SBAR(); GAPA(c1=__builtin_amdgcn_mfma_f32_32x32x16_bf16(kf[3],qr[1],c1,0,0,0)); \
    VRD(2); SBAR(); GAPA(c0=__builtin_amdgcn_mfma_f32_32x32x16_bf16(kf[4],qr[2],c0,0,0,0)); \
    VRD(6); SBAR(); GAPA(c1=__builtin_amdgcn_mfma_f32_32x32x16_bf16(kf[5],qr[2],c1,0,0,0)); \
    VRD(3); SBAR(); GAPA(c0=__builtin_amdgcn_mfma_f32_32x32x16_bf16(kf[6],qr[3],c0,0,0,0)); \
    VRD(7); SBAR(); GAPA(c1=__builtin_amdgcn_mfma_f32_32x32x16_bf16(kf[7],qr[3],c1,0,0,0)); \
    if(__builtin_constant_p(GK)&&(GK)&&(GV)){ glds16s3(Kh+(long)((t)+3)*KVBLK*ZP,koff,(unsigned)__builtin_amdgcn_readfirstlane(kdst+sl_cur),Vh+(long)((t)+1)*KVBLK*ZP,voff,(unsigned)__builtin_amdgcn_readfirstlane(vdst+2*sl_next)); } \
    else { if(GK){DMA_K((t)+3,sl_cur);} if(GV){DMA_V((t)+1,sl_next);} } \
    { const int jb_=(t)-(NT-4); if(jb_>=-3)dbias(c0,c1,jb_,wid,r32,hi,tbl); } \
    if constexpr(NOMAX){ SBAR(); float sacc=0.f; \
      GAPB(o[0]=__builtin_amdgcn_mfma_f32_32x32x16_bf16(PAF(SP,0),VFR(0),o[0],0,0,0), c0,0,SN##0,0); VRDB(0); \
      GAPB(o[1]=__builtin_amdgcn_mfma_f32_32x32x16_bf16(PAF(SP,0),VFR(4),o[1],0,0,0), c0,2,SN##0,1); VRDB(4); \
      KRD(GL,0); GAPB(o[0]=__builtin_amdgcn_mfma_f32_32x32x16_bf16(PAF(SP,1),VFR(1),o[0],0,0,0), c0,4,SN##0,2); VRDB(1); \
      KRD(GL,1); GAPB(o[1]=__builtin_amdgcn_mfma_f32_32x32x16_bf16(PAF(SP,1),VFR(5),o[1],0,0,0), c0,6,SN##0,3); VRDB(5); \
      KRD(GL,2); GAPB(o[0]=__builtin_amdgcn_mfma_f32_32x32x16_bf16(PAF(SP,2),VFR(2),o[0],0,0,0), c0,8,SN##1,0); VRDB(2); \
      KRD(GL,3); GAPB(o[1]=__builtin_amdgcn_mfma_f32_32x32x16_bf16(PAF(SP,2),VFR(6),o[1],0,0,0), c0,10,SN##1,1); VRDB(6); \
      GAPB(o[0]=__builtin_amdgcn_mfma_f32_32x32x16_bf16(PAF(SP,3),VFR(3),o[0],0,0,0), c0,12,SN##1,2); VRDB(3); \
      GAPB(o[1]=__builtin_amdgcn_mfma_f32_32x32x16_bf16(PAF(SP,3),VFR(7),o[1],0,0,0), c0,14,SN##1,3); VRDB(7); \
      GAPB(o[2]=__builtin_amdgcn_mfma_f32_32x32x16_bf16(PAF(SP,0),VFR(0),o[2],0,0,0), c1,0,SN##2,0); \
      GAPB(o[3]=__builtin_amdgcn_mfma_f32_32x32x16_bf16(PAF(SP,0),VFR(4),o[3],0,0,0), c1,2,SN##2,1); \
      GAPB(o[2]=__builtin_amdgcn_mfma_f32_32x32x16_bf16(PAF(SP,1),VFR(1),o[2],0,0,0), c1,4,SN##2,2); \
      GAPB(o[3]=__builtin_amdgcn_mfma_f32_32x32x16_bf16(PAF(SP,1),VFR(5),o[3],0,0,0), c1,6,SN##2,3); \
      GAPB(o[2]=__builtin_amdgcn_mfma_f32_32x32x16_bf16(PAF(SP,2),VFR(2),o[2],0,0,0), c1,8,SN##3,0); \
      GAPB(o[3]=__builtin_amdgcn_mfma_f32_32x32x16_bf16(PAF(SP,2),VFR(6),o[3],0,0,0), c1,10,SN##3,1); \
      GAPB(o[2]=__builtin_amdgcn_mfma_f32_32x32x16_bf16(PAF(SP,3),VFR(3),o[2],0,0,0), c1,12,SN##3,2); \
      GAPB(o[3]=__builtin_amdgcn_mfma_f32_32x32x16_bf16(PAF(SP,3),VFR(7),o[3],0,0,0), c1,14,SN##3,3); \
      l_reg+=sacc; \
    } else { \
    SBAR(); \
      \
    o[0]=__builtin_amdgcn_mfma_f32_32x32x16_bf16(PAF(SP,0),VFR(0),o[0],0,0,0); VRDB(0); float a=MX3(c0[0],c0[1],c1[0]),b=MX3(c0[2],c0[3],c1[1]); a=MX3(a,c1[2],c1[3]); SBAR(); \
    o[1]=__builtin_amdgcn_mfma_f32_32x32x16_bf16(PAF(SP,0),VFR(4),o[1],0,0,0); VRDB(4); a=MX3(a,c0[4],c0[5]);b=MX3(b,c0[6],c0[7]);a=MX3(a,c1[4],c1[5]);b=MX3(b,c1[6],c1[7]); SBAR(); \
    KRD(GL,0); o[0]=__builtin_amdgcn_mfma_f32_32x32x16_bf16(PAF(SP,1),VFR(1),o[0],0,0,0); VRDB(1); a=MX3(a,c0[8],c0[9]);b=MX3(b,c0[10],c0[11]);a=MX3(a,c1[8],c1[9]);b=MX3(b,c1[10],c1[11]); SBAR(); \
    KRD(GL,1); o[1]=__builtin_amdgcn_mfma_f32_32x32x16_bf16(PAF(SP,1),VFR(5),o[1],0,0,0); VRDB(5); a=MX3(a,c0[12],c0[13]);b=MX3(b,c0[14],c0[15]);a=MX3(a,c1[12],c1[13]);b=MX3(b,c1[14],c1[15]); SBAR(); \
    KRD(GL,2); o[0]=__builtin_amdgcn_mfma_f32_32x32x16_bf16(PAF(SP,2),VFR(2),o[0],0,0,0); VRDB(2); \
    float rm=__builtin_fmaxf(a,b); { auto rr=__builtin_amdgcn_permlane32_swap(__float_as_uint(rm),__float_as_uint(rm),false,false); rm=__builtin_fmaxf(__uint_as_float(rr[0]),__uint_as_float(rr[1])); } \
    resc=false; const float rel=rm-mhat;                \
    if(__builtin_expect(__any(rel>(float)THRL),0)){ const float dl=__builtin_fmaxf(rel,0.f); mhat+=dl; \
      const float f=__builtin_amdgcn_exp2f(-dl); l_reg*=f; if(hi==0)wsf[r32]=f; resc=true; } \
    float ref=mhat; asm volatile("":"+v"(ref):"v"(rm));     \
    SBAR(); \
    KRD(GL,3); o[1]=__builtin_amdgcn_mfma_f32_32x32x16_bf16(PAF(SP,2),VFR(6),o[1],0,0,0); VRDB(6); _Pragma("unroll") for(int r=0;r<6;++r){c0[r]=fsub_s(c0[r],ref);c1[r]=fsub_s(c1[r],ref);} SBAR(); \
    o[0]=__builtin_amdgcn_mfma_f32_32x32x16_bf16(PAF(SP,3),VFR(3),o[0],0,0,0); VRDB(3); _Pragma("unroll") for(int r=6;r<11;++r){c0[r]=fsub_s(c0[r],ref);c1[r]=fsub_s(c1[r],ref);} SBAR(); \
    o[1]=__builtin_amdgcn_mfma_f32_32x32x16_bf16(PAF(SP,3),VFR(7),o[1],0,0,0); VRDB(7); _Pragma("unroll") for(int r=11;r<16;++r){c0[r]=fsub_s(c0[r],ref);c1[r]=fsub_s(c1[r],ref);} SBAR(); \
    float sacc=0.f; \
    GAPB4(o[2]=__builtin_amdgcn_mfma_f32_32x32x16_bf16(PAF(SP,0),VFR(0),o[2],0,0,0), c0,0,SN##0,0); \
    GAPB4(o[3]=__builtin_amdgcn_mfma_f32_32x32x16_bf16(PAF(SP,0),VFR(4),o[3],0,0,0), c0,4,SN##0,2); \
    GAPB4(o[2]=__builtin_amdgcn_mfma_f32_32x32x16_bf16(PAF(SP,1),VFR(1),o[2],0,0,0), c0,8,SN##1,0); \
    GAPB4(o[3]=__builtin_amdgcn_mfma_f32_32x32x16_bf16(PAF(SP,1),VFR(5),o[3],0,0,0), c0,12,SN##1,2); \
    GAPB4(o[2]=__builtin_amdgcn_mfma_f32_32x32x16_bf16(PAF(SP,2),VFR(2),o[2],0,0,0), c1,0,SN##2,0); \
    GAPB4(o[3]=__builtin_amdgcn_mfma_f32_32x32x16_bf16(PAF(SP,2),VFR(6),o[3],0,0,0), c1,4,SN##2,2); \
    GAPB4(o[2]=__builtin_amdgcn_mfma_f32_32x32x16_bf16(PAF(SP,3),VFR(3),o[2],0,0,0), c1,8,SN##3,0); \
    GAPB4(o[3]=__builtin_amdgcn_mfma_f32_32x32x16_bf16(PAF(SP,3),VFR(7),o[3],0,0,0), c1,12,SN##3,2); \
    l_reg+=sacc; } \
    }while(0)
  int t=1;
  for(;t+7<NT;t+=2){
    STEP(pa,pb,t,true,true,true);     WAIT_BAR(3); RESC(); ROT();
    STEP(pb,pa,t+1,true,true,true);   WAIT_BAR(3); RESC(); ROT();
  }
  #define ENDW(tt) do{ if((tt)+3<NT){WAIT_BAR(3);} else if((tt)+2<NT){WAIT_BAR(2);} else {WAIT_BAR(0);} }while(0)
  for(;t+1<NT;t+=2){
    STEP(pa,pb,t,(t+3<NT),(t+1<NT),(t+1<NT));       ENDW(t);   RESC(); ROT();
    STEP(pb,pa,t+1,(t+4<NT),(t+2<NT),(t+2<NT));     ENDW(t+1); RESC(); ROT();
  }
  STEP(pa,pb,NT-1,false,false,false); RESC();
  { SBAR(); pv(o,vb0+2*sl_cur,PAF(pb,0),PAF(pb,1),PAF(pb,2),PAF(pb,3)); pv(o+2,vb0+2*sl_cur+8192,PAF(pb,0),PAF(pb,1),PAF(pb,2),PAF(pb,3)); }
  #undef PKW
  #undef PAF
  #undef VFR
  #undef PIN
  #undef MX3
  #undef GAPA
  #undef GAPB
  #undef GAPB4
  #undef EX
  #undef VRD
  #undef VRDB
  #undef KRD
  #undef STEP
  #undef ENDW
  #undef FIX
  {auto rr=__builtin_amdgcn_permlane32_swap(__float_as_uint(l_reg),__float_as_uint(l_reg),false,false);l_reg=__uint_as_float(rr[0])+__uint_as_float(rr[1]);}
  if(hi==0)wsf[32+r32]=l_reg;asm volatile("s_waitcnt lgkmcnt(0)":::"memory");
  float rli[16];
  #pragma unroll
  for(int r=0;r<16;++r)rli[r]=__builtin_amdgcn_rcpf(wsf[32+crow(r,hi)]);
  { bf16*stg=(bf16*)(shm+D2_OST)+wid*4096;
    #pragma unroll
    for(int r=0;r<16;++r){const int orow=crow(r,hi);
      #pragma unroll
      for(int d0=0;d0<4;++d0){ float val=o[d0][r]*rli[r];
        if(EPI==2){ val=__bfloat162float(stg[orow*128+d0*32+r32])-lam*val; }
        stg[orow*128+d0*32+r32]=__float2bfloat16(val);}} }
  asm volatile("s_waitcnt lgkmcnt(0)\n\ts_barrier":::"memory");
  #undef DMA_K
  #undef DMA_V
  #undef RESC
  #undef ROT
}

#ifndef ATT_SEL_DIFF
#define ATT_SEL_DIFF true
#endif
#ifndef ATT_SEL_FOX
#define ATT_SEL_FOX true
#endif
typedef __attribute__((address_space(3))) unsigned ldsu;
struct AttnParams { const bf16* Z; bf16* MIX; const float* logf2; const float* tab; const float* subg; unsigned* counter; const unsigned* nrm; float lam; float osc; };
#define FULL_BAR() asm volatile("s_waitcnt vmcnt(0) lgkmcnt(0)\n\ts_barrier":::"memory")
__device__ __forceinline__ void fox_scan(const float*lf,int n,char*shm){
  ldsf*csl=(ldsf*)(lds_cptr)shm+LDS_CS/4; ldsf*wsum=(ldsf*)(lds_cptr)shm+(LDS_AUX+64)/4;
  int tid_=threadIdx.x; asm volatile("":"+v"(tid_)); const int tid=tid_,lane=tid&63; const int wid=__builtin_amdgcn_readfirstlane(tid>>6);
  const bool act=32*tid<n; float v[32]; float tot=0.f;
  #pragma unroll
  for(int j=0;j<32;++j)v[j]=0.f;
  if(act){ const f32x4a*p=(const f32x4a*)(lf+32*tid);
    #pragma unroll
    for(int k=0;k<8;++k){const f32x4a a=p[k];v[4*k]=a[0];v[4*k+1]=a[1];v[4*k+2]=a[2];v[4*k+3]=a[3];}
    #pragma unroll
    for(int j=0;j<32;++j){tot+=v[j];v[j]=tot;} }
  float inc=tot;
  #pragma unroll
  for(int o=1;o<64;o<<=1){const float tt=shl_(inc,(lane-o)&63,lane); if(lane>=o)inc+=tt;}
  if(lane==63)wsum[wid]=inc;
  FULL_BAR();
  float off=inc-tot;
  for(int w=0;w<wid;++w)off+=wsum[w];
  if(act){
    #pragma unroll
    for(int k=0;k<8;++k){ f32x4a a; a[0]=v[4*k]+off;a[1]=v[4*k+1]+off;a[2]=v[4*k+2]+off;a[3]=v[4*k+3]+off; *(__attribute__((address_space(3))) f32x4a*)(csl+32*tid+4*k)=a; } }
}
__device__ __forceinline__ void diff_table(const float*tab,int h,char*shm){
  ldsf*tb=(ldsf*)(lds_cptr)shm+D2_TBL/4; int i=threadIdx.x; asm volatile("":"+v"(i));
  const int rel=i-447,n=rel<0?-rel:rel;
  const int f=n<8?n:n<12?8:n<16?9:n<23?10:n<32?11:n<46?12:n<64?13:n<91?14:15;
  const int bucket=(rel>0?16:0)+f;
  tb[i]=(i<511)?(tab[bucket*4+h]-tab[15*4+h])*LOG2E:0.f;
}
__device__ __forceinline__ void diff_finish(bf16*Ow,const float*g,float osc,char*shm){
  int tid_=threadIdx.x; asm volatile("":"+v"(tid_)); const int lane=tid_&63; const int wid=__builtin_amdgcn_readfirstlane(tid_>>6);
  const bf16*st=(const bf16*)(shm+D2_OST)+wid*4096;
  const int ch=lane&15; float ga[8];
  #pragma unroll
  for(int j=0;j<8;++j)ga[j]=g[ch*8+j];
  #pragma unroll
  for(int i=0;i<8;++i){ const int row=i*4+(lane>>4);
    const u32x4 a=*(const u32x4*)(st+row*128+ch*8);
    float va[8];
    #pragma unroll
    for(int j=0;j<4;++j){ va[2*j]=__uint_as_float(a[j]<<16); va[2*j+1]=__uint_as_float(a[j]&0xffff0000u); }
    float ss=0.f;
    #pragma unroll
    for(int j=0;j<8;++j)ss+=va[j]*va[j];
    ss+=shx(ss,1,lane);ss+=shx(ss,2,lane);ss+=shx(ss,4,lane);ss+=shx(ss,8,lane);
    const float r=osc/sqrtf(ss*(1.f/128.f)+1e-5f);
    u32x4 oa;
    #pragma unroll
    for(int j=0;j<4;++j)oa[j]=cvtpk_s(va[2*j]*r*ga[2*j],va[2*j+1]*r*ga[2*j+1]);
    *(u32x4*)(Ow+(long)row*OP+ch*8)=oa; }
}
template<int THRL> __device__ __forceinline__ void attn_phase(char*lds,const AttnParams&P){
  const int tid=threadIdx.x; const int wid=__builtin_amdgcn_readfirstlane(tid>>6);
  volatile ldsu*qw=(volatile ldsu*)(lds_cptr)lds+LDS_AUX/4;
  #define GRAB(dst) do{ if(tid==0){ *qw=atomicAdd(P.counter,1u); } FULL_BAR(); dst=__builtin_amdgcn_readfirstlane((int)*qw); }while(0)
  int idx; GRAB(idx);
  while(ATT_SEL_DIFF&&idx<512){ const int qb=63-(idx>>3),bh=idx&7,b=bh>>2,h=bh&3;
    const bf16*zb=P.Z+(long)b*SEQ*ZP;
    diff_table(P.tab,h,lds);
    float bmax=0.f;
    for(int i=0;i<32;++i)bmax=fmaxf(bmax,fabsf(P.tab[i*4+h]-P.tab[60+h])*LOG2E);
    for(int mp=0;mp<2;++mp){
      const unsigned*nq=P.nrm+((2*2+b)*8+2*h+mp)*2,*nk=P.nrm+((3*2+b)*8+2*h+mp)*2;
      const float nq2=__uint_as_float(nq[0])+__uint_as_float(nq[1]),nk2=__uint_as_float(nk[0])+__uint_as_float(nk[1]);
      const float bound=1.02f*sqrtf(nq2*nk2)+bmax;
      const int fast=__builtin_amdgcn_readfirstlane(bound<60.f?1:0);
      if(fast) attn_unit2<THRL,true>(qb,zb+1536+h*128+mp*64,zb+2048+h*128+mp*64,zb+2560+h*128,lds,mp?2:1,P.lam);
      else     attn_unit2<THRL,false>(qb,zb+1536+h*128+mp*64,zb+2048+h*128+mp*64,zb+2560+h*128,lds,mp?2:1,P.lam); }
    diff_finish(P.MIX+((long)b*SEQ+qb*QB+wid*QBLK)*OP+512+h*128,P.subg,P.osc,lds);
    GRAB(idx);
  }
  while(ATT_SEL_FOX&&idx<1536){ const int j=idx-512,qb=63-(j>>4),bh=j&15,b=bh>>3,h=bh&7;
    const bf16*zb=P.Z+(long)b*SEQ*ZP;
    fox_scan(P.logf2+(long)(b*8+h)*SEQ,256*(qb+1),lds);
    { int tid_=threadIdx.x; asm volatile("":"+v"(tid_)); const int ln=tid_&63,row=tid_>>1,hf=tid_&1;
      const u32x4*qp=(const u32x4*)(zb+h*64+(long)(256*qb+row)*ZP+hf*32),*kp=(const u32x4*)(zb+512+h*64+(long)(256*qb+row)*ZP+hf*32);
      float dot=0.f,qq=0.f;
      #pragma unroll
      for(int i=0;i<4;++i){ const u32x4 a=qp[i],c=kp[i];
        #pragma unroll
        for(int j=0;j<4;++j){ const float q0_=__uint_as_float(a[j]<<16),q1_=__uint_as_float(a[j]&0xffff0000u),k0_=__uint_as_float(c[j]<<16),k1_=__uint_as_float(c[j]&0xffff0000u);
          dot+=q0_*k0_+q1_*k1_; qq+=q0_*q0_+q1_*q1_; } }
      dot+=shx(dot,1,ln); qq+=shx(qq,1,ln);
      #pragma unroll
      for(int o=2;o<64;o<<=1){ dot=fminf(dot,shx(dot,o,ln)); qq=fmaxf(qq,shx(qq,o,ln)); }
      ldsf*st=(ldsf*)(lds_cptr)lds+(LDS_AUX+128)/4; if(ln==0){ st[wid]=dot; st[8+wid]=qq; } }
    FULL_BAR();
    int kt0=0,fastfox=0;
    { const unsigned*nk=P.nrm+((1*2+b)*8+h)*2; cldsf*st=(cldsf*)(lds_cptr)lds+(LDS_AUX+128)/4;
      float dmin=st[0],nq2=st[8];
      #pragma unroll
      for(int w=1;w<8;++w){ dmin=fminf(dmin,st[w]); nq2=fmaxf(nq2,st[8+w]); }
      const float nk2=__uint_as_float(nk[0])+__uint_as_float(nk[1]);
      const float nqk=1.02f*sqrtf(nq2*nk2); fastfox=__builtin_amdgcn_readfirstlane(nqk<60.f?1:0);
      const float thr=nqk-dmin+32.5f;
      cldsf*csl=(cldsf*)(lds_cptr)lds+LDS_CS/4; const float cq=csl[256*qb];
      int lo_=0,hi_=4*qb;
      while(lo_<hi_){ const int mid=(lo_+hi_)>>1; if(csl[64*mid+63]-cq>thr)lo_=mid+1; else hi_=mid; }
      kt0=__builtin_amdgcn_readfirstlane(lo_)&~1; }
    if(fastfox) attn_unit<0,2*THRL,true>(qb,kt0,zb+h*64,zb+512+h*64,zb+1024+h*64,P.MIX+(long)b*SEQ*OP+h*64,lds,0,LDS_OST,0.f);
    else        attn_unit<0,2*THRL,false>(qb,kt0,zb+h*64,zb+512+h*64,zb+1024+h*64,P.MIX+(long)b*SEQ*OP+h*64,lds,0,LDS_OST,0.f);
    GRAB(idx);
  }
  #undef GRAB
}
#undef FULL_BAR
#undef SBAR
#undef WAIT_BAR
}
#include <hip/hip_cooperative_groups.h>
namespace cg = cooperative_groups;
#ifndef MK_ONE_LAUNCH
#define MK_ONE_LAUNCH 1
#endif
constexpr int NWAVES = 8;
#ifndef MK_MSPLIT
#define MK_MSPLIT 2
#endif
constexpr int MSPLIT = MK_MSPLIT;
constexpr int BATCH = 2, T = 16384, D = 1024, FF = 4096, M = BATCH * T, NIN = 3328, NINSRC = 3080, DEPTH = 2;
constexpr size_t MiB = 1u << 20;
constexpr size_t WS_CTL = 0, CTL_ZERO_BYTES = 65536;
constexpr int CW_BAR = 4096, CW_NRM = 1024;
constexpr size_t WS_WIN = 2 * MiB, WIN_BYTES = (size_t)NIN * D * 2;
constexpr size_t WS_WO = 16 * MiB, WO_BYTES = (size_t)D * D * 2;
constexpr size_t WS_W1 = 20 * MiB, W1_BYTES = (size_t)D * FF * 2;
constexpr size_t WS_W2 = 36 * MiB, W2_BYTES = (size_t)D * FF * 2;
constexpr size_t WS_SSQ = 52 * MiB;
constexpr size_t WS_DUMP = 56 * MiB;
constexpr size_t WS_LOGF = 54 * MiB;
constexpr size_t WS_XB = 64 * MiB;
constexpr size_t WS_MIX = 128 * MiB;
constexpr size_t WS_Z = 192 * MiB;
constexpr size_t WS_H = 128 * MiB;
constexpr size_t WS_END = 384 * MiB;
static_assert(WS_WIN + 2 * WIN_BYTES <= WS_WO && WS_WO + 2 * WO_BYTES <= WS_W1 && WS_W1 + 2 * W1_BYTES <= WS_W2 && WS_W2 + 2 * W2_BYTES <= WS_SSQ, "ws map");
static_assert(WS_H + (size_t)M * FF * 2 <= WS_END && WS_Z + (size_t)M * 3072 * 2 <= WS_END, "ws map 2");
constexpr int RING_BYTES = 131072, EPI_LDS_OFF = RING_BYTES;
constexpr int PARAM_OFF = (attn_body::LDS_TOTAL > RING_BYTES + 4096) ? attn_body::LDS_TOTAL : RING_BYTES + 4096;
constexpr int XB_ST_OFF = PARAM_OFF + 192;
constexpr int LDS_BYTES = PARAM_OFF + 256;
constexpr int RTAB_OFF = RING_BYTES + 4096 + 256;
static_assert(RTAB_OFF + 8 * 256 * 4 <= PARAM_OFF, "rstd table");
static_assert(LDS_BYTES <= 160 * 1024, "LDS");

#define LAS __attribute__((address_space(3)))
typedef unsigned short bf16;
typedef unsigned v4u __attribute__((ext_vector_type(4)));
typedef float f32x4 __attribute__((ext_vector_type(4)));
__device__ __forceinline__ unsigned f2bf(float f) { unsigned u = __builtin_bit_cast(unsigned, f); return (u + 0x7fffu + ((u >> 16) & 1u)) >> 16; }
__device__ __forceinline__ unsigned pk2(float lo, float hi) { return f2bf(lo) | (f2bf(hi) << 16); }
__device__ __forceinline__ float wave_sum(float v, int lane) {
#pragma unroll
    for (int o = 1; o < 64; o <<= 1) v += shx(v, o, lane);
    return v;
}
template <bool MAPIN>
__device__ __forceinline__ void p0_transpose_item(const float* W, int K, int Nsrc, int nblk, const float* gain, bf16* WT, LAS float* scr, int item, int lane) {
    const int kb = __builtin_amdgcn_readfirstlane(item / nblk), nb = __builtin_amdgcn_readfirstlane(item % nblk), k0 = 64 * kb, n0 = 32 * nb;
    const int ch = lane & 7, rr = lane >> 3;
    const int nn = n0 + 4 * ch;
    int src = nn; if (MAPIN) src = nn < 1536 ? nn : (nn < 3072 ? nn + 8 : (nn < 3080 ? nn - 1536 : -1));
    f32x4 v[8];
#pragma unroll
    for (int i = 0; i < 8; ++i) { const int kk = 8 * i + rr; v[i] = (f32x4){0.f, 0.f, 0.f, 0.f}; if (src >= 0) v[i] = *(const f32x4*)(W + (size_t)(k0 + kk) * Nsrc + src); }
#pragma unroll
    for (int i = 0; i < 8; ++i) { const int kk = 8 * i + rr; f32x4 w = v[i]; if (gain) w = w * gain[k0 + kk];
        scr[kk * 33 + 4 * ch + 0] = w[0]; scr[kk * 33 + 4 * ch + 1] = w[1]; scr[kk * 33 + 4 * ch + 2] = w[2]; scr[kk * 33 + 4 * ch + 3] = w[3]; }
    asm volatile("s_waitcnt lgkmcnt(0)" ::: "memory");
    const int c = lane & 7;
#pragma unroll
    for (int j = 0; j < 4; ++j) { const int n = (lane >> 3) + 8 * j; const LAS float* s = scr + (8 * c) * 33 + n;
        v4u o; o.x = pk2(s[0 * 33], s[1 * 33]); o.y = pk2(s[2 * 33], s[3 * 33]); o.z = pk2(s[4 * 33], s[5 * 33]); o.w = pk2(s[6 * 33], s[7 * 33]);
        *(v4u*)(WT + (size_t)(n0 + n) * K + k0 + 8 * c) = o; }
    asm volatile("s_waitcnt lgkmcnt(0)" ::: "memory");
}

#define XB_TMO      128
#define XB_XCNT(j)  (256  + 64 * (j))
#define XB_XSUB(j)  (1280 + 64 * (j))
#define XB_XGEN(j)  (2304 + 64 * (j))
#define XB_TOP      3328
#define XB_TOPGEN   3392
#define XCD_BAR_WORDS 3456
#define XB_SPIN_CAP (1u << 18)

__device__ __forceinline__ unsigned xb_ld(unsigned* p)              { return __hip_atomic_load(p, __ATOMIC_RELAXED, __HIP_MEMORY_SCOPE_AGENT); }
__device__ __forceinline__ unsigned xb_add(unsigned* p, unsigned v) { return __hip_atomic_fetch_add(p, v, __ATOMIC_RELAXED, __HIP_MEMORY_SCOPE_AGENT); }
__device__ __forceinline__ unsigned xb_xcc_id() { return (unsigned)__builtin_amdgcn_s_getreg((3 << 11) | 20) & 0xFu; }
#define XB_SPIN(cond, bar) do { unsigned _sp = 0; while (cond) { __builtin_amdgcn_s_sleep(1); \
    if ((++_sp & 255u) == 0u) { if (xb_ld(&(bar)[XB_TMO])) break; if (_sp > XB_SPIN_CAP) { atomicAdd(&(bar)[XB_TMO], 1u); break; } } } } while (0)

struct XcdBarrier {
    unsigned* bar; unsigned x;
    volatile LAS unsigned* st;
};

__device__ __forceinline__ XcdBarrier xcd_barrier_post(unsigned* bar, volatile LAS unsigned* st) {
    XcdBarrier b; b.bar = bar; b.x = xb_xcc_id(); b.st = st;
    if (threadIdx.x == 0) (void)xb_add(&bar[XB_XCNT(b.x)], 1u);
    return b;
}
__device__ __forceinline__ void xcd_barrier_complete(unsigned* bar, unsigned x, unsigned& nloc, unsigned& nx) {
    const unsigned G = gridDim.x * gridDim.y * gridDim.z;
    unsigned sum, cnt, mine, sp = 0u;
    for (;;) {
        sum = 0u; cnt = 0u; mine = 0u;
#pragma unroll
        for (unsigned j = 0; j < 16; ++j) { const unsigned c = xb_ld(&bar[XB_XCNT(j)]); sum += c; cnt += (c > 0u) ? 1u : 0u; mine = (j == x) ? c : mine; }
        if (sum == G) break;
        __builtin_amdgcn_s_sleep(1);
        if ((++sp & 255u) == 0u) { if (xb_ld(&bar[XB_TMO])) break; if (sp > XB_SPIN_CAP) { atomicAdd(&bar[XB_TMO], 1u); break; } }
    }
    nloc = mine > 0u ? mine : 1u; nx = cnt > 0u ? cnt : 1u;
}

__device__ __forceinline__ void xcd_barrier(const XcdBarrier& b) {
    asm volatile("s_waitcnt vmcnt(0)" ::: "memory");
    __syncthreads();
    if (threadIdx.x == 0) {
        unsigned* bar = b.bar;
        __builtin_amdgcn_s_waitcnt(0);
        unsigned nloc = b.st[0], nx = b.st[1];
        if (nloc == 0u) { xcd_barrier_complete(bar, b.x, nloc, nx); b.st[0] = nloc; b.st[1] = nx; }
        const unsigned old = xb_add(&bar[XB_XSUB(b.x)], 1u);
        const unsigned gen = old / nloc;
        if (old + 1u == (gen + 1u) * nloc) {
            __builtin_amdgcn_fence(__ATOMIC_RELEASE, "agent");
            asm volatile("s_waitcnt vmcnt(0)" ::: "memory");
            const unsigned og = xb_add(&bar[XB_TOP], 1u);
            const unsigned tg = og / nx;
            if (og + 1u == (tg + 1u) * nx) xb_add(&bar[XB_TOPGEN], 1u);
            else XB_SPIN(xb_ld(&bar[XB_TOPGEN]) == tg, bar);
            __builtin_amdgcn_fence(__ATOMIC_ACQUIRE, "agent");
            xb_add(&bar[XB_XGEN(b.x)], 1u);
            asm volatile("s_waitcnt vmcnt(0)" ::: "memory");
        } else {
            XB_SPIN(xb_ld(&bar[XB_XGEN(b.x)]) == gen, bar);
            __builtin_amdgcn_fence(__ATOMIC_ACQUIRE, "agent");
            asm volatile("s_waitcnt vmcnt(0)" ::: "memory");
        }
    }
    __syncthreads();
}

__device__ __forceinline__ int opqv(int v) { asm volatile("" : "+v"(v)); return v; }
__device__ __forceinline__ int opq(int v) { asm volatile("" : "+s"(v)); return v; }
__device__ __forceinline__ const float* ldprm(LAS unsigned char* l, int i) {
    volatile LAS unsigned* p = (volatile LAS unsigned*)(l + PARAM_OFF) + 2 * i; unsigned a = p[0], b = p[1];
    a = __builtin_amdgcn_readfirstlane(a); b = __builtin_amdgcn_readfirstlane(b);
    return (const float*)(const __attribute__((address_space(1))) float*)(((unsigned long long)b << 32) | a);
}
struct Args { const float* in[15]; float* out; unsigned char* ws; int ph_lo, ph_hi; };
__global__ void __launch_bounds__(NWAVES * 64, 2) fwd_megakernel(Args args) {
    extern __shared__ __attribute__((aligned(16))) unsigned char lds[];
    LAS unsigned char* ldsl = (LAS unsigned char*)lds;
    const int tid = threadIdx.x, wave = __builtin_amdgcn_readfirstlane(tid >> 6);
#define lane (opqv((int)threadIdx.x) & 63)
    const int G = gridDim.x;
    if (tid == 0) { volatile LAS unsigned long long* pp = (volatile LAS unsigned long long*)(ldsl + PARAM_OFF);
#pragma unroll
        for (int i = 0; i < 15; ++i) pp[i] = (unsigned long long)args.in[i];
        pp[15] = (unsigned long long)args.out; pp[16] = (unsigned long long)args.ws;
        ((volatile LAS unsigned*)(ldsl + XB_ST_OFF))[0] = 0u; ((volatile LAS unsigned*)(ldsl + XB_ST_OFF))[1] = 0u; }
    __syncthreads();
    (void)xcd_barrier_post((unsigned*)(args.ws + WS_CTL) + CW_BAR, (volatile LAS unsigned*)(ldsl + XB_ST_OFF));
#define INP(i) ldprm(ldsl, (i))
#define OUTP ((float*)ldprm(ldsl, 15))
#define WSP ((unsigned char*)ldprm(ldsl, 16))
#define XB ((bf16*)(ws + WS_XB))
#define MIX ((bf16*)(ws + WS_MIX))
#define Z ((bf16*)(ws + WS_Z))
#define HB ((bf16*)(ws + WS_H))
#define SSQ ((float*)(ws + WS_SSQ))
#define LOGF ((float*)(ws + WS_LOGF))
    const int lo = args.ph_lo, hi = args.ph_hi;
#ifndef PHMASK
#define PHMASK 0xfff
#endif
#define IN(k) (((PHMASK >> ((k) > 5 && (k) < 11 ? (k) - 5 : (k))) & 1) && lo <= (k) && (k) < hi)
#ifndef DUPMASK
#define DUPMASK 0
#endif
#define REPS(bit) ((((DUPMASK) >> (bit)) & 1) + 1)
#define XBAR() do { XcdBarrier xb_; xb_.bar = (unsigned*)(WSP + WS_CTL) + CW_BAR; xb_.x = xb_xcc_id(); xb_.st = (volatile LAS unsigned*)(ldsl + XB_ST_OFF); xcd_barrier(xb_); } while (0)
#define SEAM(k) do { if (IN(k) && IN((k) + 1)) { if (lo < 0) cg::this_grid().sync(); else { XcdBarrier xb_; xb_.bar = (unsigned*)(WSP + WS_CTL) + CW_BAR; xb_.x = xb_xcc_id(); xb_.st = (volatile LAS unsigned*)(ldsl + XB_ST_OFF); xcd_barrier(xb_); } } } while (0)

    if (IN(0)) {
        LAS float* scr = (LAS float*)(ldsl + wave * 16384); unsigned char* ws = WSP; const float* x_in = INP(0);
        const float *w_in = INP(1), *w_out = INP(8), *g_att = INP(9), *g_mlp = INP(10), *w_1 = INP(11), *w_2 = INP(12);
        const int gw = blockIdx.x * NWAVES + wave, NGW = G * NWAVES;
        constexpr int I_IN = (D / 64) * (NIN / 32), I_O = (D / 64) * (D / 32), I_1 = (D / 64) * (FF / 32), I_2 = (FF / 64) * (D / 32), I_L = I_IN + I_O + I_1 + I_2;
        for (int it = gw; it < DEPTH * I_L; it += NGW) {
            const int l = __builtin_amdgcn_readfirstlane(it / I_L); int r = __builtin_amdgcn_readfirstlane(it % I_L);
            if (r < I_IN) { p0_transpose_item<true>(w_in + (size_t)l * D * NINSRC, D, NINSRC, NIN / 32, g_att + l * D, (bf16*)(ws + WS_WIN + l * WIN_BYTES), scr, r, lane); continue; } r -= I_IN;
            if (r < I_O) { p0_transpose_item<false>(w_out + (size_t)l * D * D, D, D, D / 32, nullptr, (bf16*)(ws + WS_WO + l * WO_BYTES), scr, r, lane); continue; } r -= I_O;
            if (r < I_1) { p0_transpose_item<false>(w_1 + (size_t)l * D * FF, D, FF, FF / 32, g_mlp + l * D, (bf16*)(ws + WS_W1 + l * W1_BYTES), scr, r, lane); continue; } r -= I_1;
            p0_transpose_item<false>(w_2 + (size_t)l * FF * D, FF, D, D / 32, nullptr, (bf16*)(ws + WS_W2 + l * W2_BYTES), scr, r, lane);
        }
        for (int m0 = gw * 4; m0 < M; m0 += NGW * 4) {
            const int ln = lane; f32x4 v[4][4]; float s[4];
#pragma unroll
            for (int q = 0; q < 4; ++q) { const f32x4* xr = (const f32x4*)(x_in + (size_t)(m0 + q) * D) + ln;
#pragma unroll
                for (int j = 0; j < 4; ++j) v[q][j] = xr[64 * j]; }
#pragma unroll
            for (int q = 0; q < 4; ++q) { float a = 0.f;
#pragma unroll
                for (int j = 0; j < 4; ++j) a += (v[q][j][0] * v[q][j][0] + v[q][j][1] * v[q][j][1]) + (v[q][j][2] * v[q][j][2] + v[q][j][3] * v[q][j][3]);
                s[q] = wave_sum(a, ln); }
#pragma unroll
            for (int q = 0; q < 4; ++q) { unsigned long long* o8 = (unsigned long long*)(XB + (size_t)(m0 + q) * D) + ln;
#pragma unroll
                for (int j = 0; j < 4; ++j) o8[64 * j] = (unsigned long long)pk2(v[q][j][0], v[q][j][1]) | ((unsigned long long)pk2(v[q][j][2], v[q][j][3]) << 32);
                if (ln == 0) *(f32x4*)(SSQ + (size_t)(m0 + q) * 4) = (f32x4){s[q], 0.f, 0.f, 0.f}; }
        }
    }
    SEAM(0);
    for (int l = 0; l < DEPTH; ++l) {
        const int pb = 1 + 5 * l;
        for (int rp = 0; rp < REPS(1); ++rp) { if (rp) cg::this_grid().sync();
        if (IN(pb)) { unsigned char* ws = WSP;
            pg8::Gemm g{XB, (const bf16*)(ws + WS_WIN + l * WIN_BYTES), M, 3072, D}; pg8::StaticOrder S; S.init(M, 3072, G, opq((int)blockIdx.x));
            { LAS float* rt = (LAS float*)(ldsl + RTAB_OFF); pg8::Unit uu;
              for (int i = __builtin_amdgcn_readfirstlane(opqv((int)threadIdx.x) >> 8); S.next(i, uu); i += 2) { const int r = opqv((int)threadIdx.x) & 255; rt[i * 256 + r] = pg8::row_rstd(SSQ, uu.pm * 256 + r); }
              __syncthreads(); }
            pg8::EpiInProj E{Z, (const LAS float*)(ldsl + RTAB_OFF), SSQ, INP(2) + l * 8, LOGF, (unsigned*)(ws + WS_CTL) + CW_NRM + 128 * l};
            pg8::gemm_phase<pg8::EpiInProj, pg8::StaticOrder, true, true>(ldsl, g, S, E);
            { const int ln = lane, row = ln & 15, quad = ln >> 4; const float* bfp = INP(2) + l * 8; const bf16* wf = (const bf16*)(ws + WS_WIN + l * WIN_BYTES) + (size_t)(3072 + row) * D + quad * 8;
              for (int rb = opq((int)blockIdx.x) * NWAVES + wave; rb < M / 16; rb += G * NWAVES) {
                const int m0 = rb * 16; const bf16* ap = XB + (size_t)(m0 + row) * D + quad * 8; pg8::f32x4 acc = {0.f, 0.f, 0.f, 0.f};
#pragma unroll 8
                for (int k0 = 0; k0 < D; k0 += 32) acc = __builtin_amdgcn_mfma_f32_16x16x32_bf16(*(const pg8::bf16x8*)(ap + k0), *(const pg8::bf16x8*)(wf + k0), acc, 0, 0, 0);
                if (row < 8) {
#pragma unroll
                    for (int rg = 0; rg < 4; ++rg) { const int m = m0 + quad * 4 + rg; const float z = acc[rg] * pg8::row_rstd(SSQ, m) + bfp[row];
                        const float ls = fminf(z, 0.f) - log1pf(expf(-fabsf(z)));
                        LOGF[(size_t)((m >> 14) * 8 + row) * T + (m & (T - 1))] = ls * 1.4426950408889634f; } } } }
        } }
        SEAM(pb);
        for (int rp = 0; rp < REPS(2); ++rp) { if (rp) cg::this_grid().sync();
        if (IN(pb + 1)) { unsigned char* ws = WSP;
            float d1 = INP(3)[l * 64 + lane] * INP(4)[l * 64 + lane], d2 = INP(5)[l * 64 + lane] * INP(6)[l * 64 + lane];
            d1 = wave_sum(d1, lane); d2 = wave_sum(d2, lane);
            const float li = 0.8f - 0.6f * expf(-0.3f * (float)l);
            attn_body::AttnParams P{(const attn_body::bf16*)Z, (attn_body::bf16*)MIX, LOGF, INP(13), INP(7) + l * 128, (unsigned*)(ws + WS_CTL) + 64 * (1 + l) + 16 * rp, (const unsigned*)(ws + WS_CTL) + CW_NRM + 128 * l, expf(d1) - expf(d2) + li, 1.0f - li};
            attn_body::attn_phase<8>((char*)lds, P);
        } }
        SEAM(pb + 1);
        if (IN(pb + 2)) { unsigned char* ws = WSP; float* out = OUTP;
            pg8::Gemm g{MIX, (const bf16*)(ws + WS_WO + l * WO_BYTES), M, D, D}; pg8::StaticOrder S; S.init(M, D, G, opq((int)blockIdx.x));
            pg8::EpiResid E{XB, SSQ, (LAS float*)(ldsl + EPI_LDS_OFF)};
            pg8::gemm_phase<pg8::EpiResid, pg8::StaticOrder, true, true>(ldsl, g, S, E);
        }
        SEAM(pb + 2);
        if (IN(pb + 3)) {
            for (int hf = 0; hf < MSPLIT; ++hf) { unsigned char* ws = WSP; const size_t r0 = (size_t)opq(hf * (M / MSPLIT));
                { pg8::Gemm g{XB + r0 * D, (const bf16*)(ws + WS_W1 + l * W1_BYTES), M / MSPLIT, FF, D}; pg8::StaticOrder S; S.init(M / MSPLIT, FF, G, opq((int)blockIdx.x));
                  { LAS float* rt = (LAS float*)(ldsl + RTAB_OFF); pg8::Unit uu;
                    for (int i = __builtin_amdgcn_readfirstlane(opqv((int)threadIdx.x) >> 8); S.next(i, uu); i += 2) { const int r = opqv((int)threadIdx.x) & 255; rt[i * 256 + r] = pg8::row_rstd(SSQ + r0 * 4, uu.pm * 256 + r); }
                    __syncthreads(); }
                  pg8::EpiRelu2 E{HB, (const LAS float*)(ldsl + RTAB_OFF)};
                  pg8::gemm_phase<pg8::EpiRelu2, pg8::StaticOrder, true, true>(ldsl, g, S, E); }
                XBAR();
                { pg8::Gemm g{HB, (const bf16*)(ws + WS_W2 + l * W2_BYTES), M / MSPLIT, D, FF}; pg8::StaticOrder S; S.init(M / MSPLIT, D, G, opq((int)blockIdx.x));
                  pg8::EpiResid E{XB + r0 * D, SSQ + r0 * 4, (LAS float*)(ldsl + EPI_LDS_OFF)};
                  pg8::gemm_phase<pg8::EpiResid, pg8::StaticOrder, true, true>(ldsl, g, S, E); }
                XBAR();
            }
        }
    }
    if (IN(11)) { float* out = OUTP; unsigned char* ws = WSP;
        const int gw = blockIdx.x * NWAVES + wave, NGW = G * NWAVES; const int ln = lane;
        f32x4 gv[2][2];
#pragma unroll
        for (int j = 0; j < 2; ++j) { gv[j][0] = *(const f32x4*)(INP(14) + 8 * (ln + 64 * j)); gv[j][1] = *(const f32x4*)(INP(14) + 8 * (ln + 64 * j) + 4); }
        for (int m0 = gw * 4; m0 < M; m0 += NGW * 4) {
            v4u v[4][2]; f32x4 q[4];
#pragma unroll
            for (int r = 0; r < 4; ++r) { const v4u* xr = (const v4u*)(XB + (size_t)(m0 + r) * D) + ln; v[r][0] = xr[0]; v[r][1] = xr[64]; q[r] = *(const f32x4*)(SSQ + (size_t)(m0 + r) * 4); }
#pragma unroll
            for (int r = 0; r < 4; ++r) { const float rs = 1.0f / sqrtf(((q[r][0] + q[r][1]) + (q[r][2] + q[r][3])) * (1.0f / D) + 1e-5f);
#pragma unroll
                for (int j = 0; j < 2; ++j) { const v4u w = v[r][j];
                    const f32x4 a = {__builtin_bit_cast(float, w.x << 16), __builtin_bit_cast(float, w.x & 0xffff0000u), __builtin_bit_cast(float, w.y << 16), __builtin_bit_cast(float, w.y & 0xffff0000u)};
                    const f32x4 b = {__builtin_bit_cast(float, w.z << 16), __builtin_bit_cast(float, w.z & 0xffff0000u), __builtin_bit_cast(float, w.w << 16), __builtin_bit_cast(float, w.w & 0xffff0000u)};
                    f32x4* o = (f32x4*)(out + (size_t)(m0 + r) * D + 8 * (ln + 64 * j)); o[0] = a * rs * gv[j][0]; o[1] = b * rs * gv[j][1]; } }
        }
    }
#undef IN
#undef SEAM
#undef XBAR
}

extern "C" void kernel_launch(void* const* d_in, const int* in_sizes, int n_in, void* d_out, int out_size, void* d_ws, size_t ws_size, hipStream_t stream) {
    static int grid = 0;
    if (grid == 0) {
        if (n_in != 15 || in_sizes[0] != M * D || out_size != M * D || ws_size < WS_END) { fprintf(stderr, "kernel_launch: unexpected shapes / workspace (n_in %d, ws %zu)\n", n_in, ws_size); grid = -1; return; }
        int dev = 0, cus = 0, per_cu = 0;
        hipGetDevice(&dev); hipDeviceGetAttribute(&cus, hipDeviceAttributeMultiprocessorCount, dev);
        if (hipFuncSetAttribute((const void*)fwd_megakernel, hipFuncAttributeMaxDynamicSharedMemorySize, LDS_BYTES) != hipSuccess) { fprintf(stderr, "kernel_launch: hipFuncSetAttribute failed\n"); grid = -1; return; }
        hipOccupancyMaxActiveBlocksPerMultiprocessor(&per_cu, (const void*)fwd_megakernel, NWAVES * 64, LDS_BYTES);
        (void)hipGetLastError();
        if (per_cu < 1) per_cu = 1;
        grid = cus * per_cu;
        fprintf(stderr, "kernel_launch: grid %d (%d CUs x %d)\n", grid, cus, per_cu);
    }
    if (grid < 0) return;
    hipMemsetAsync((char*)d_ws + WS_CTL, 0, CTL_ZERO_BYTES, stream);
    Args a{};
    for (int i = 0; i < 15; ++i) a.in[i] = (const float*)d_in[i];
    a.out = (float*)d_out; a.ws = (unsigned char*)d_ws;
#if MK_ONE_LAUNCH
    a.ph_lo = 0; a.ph_hi = 12;
    void* kargs[] = {&a};
    hipError_t e = hipLaunchCooperativeKernel((const void*)fwd_megakernel, dim3(grid), dim3(NWAVES * 64), kargs, LDS_BYTES, stream);
    if (e != hipSuccess) fprintf(stderr, "cooperative launch failed: %s (grid %d)\n", hipGetErrorString(e), grid);
#else
    for (int p = 0; p < 12; ++p) { a.ph_lo = p; a.ph_hi = p + 1; hipLaunchKernelGGL(fwd_megakernel, dim3(grid), dim3(NWAVES * 64), LDS_BYTES, stream, a); }
#endif
}
```

```cpp
#include <hip/hip_runtime.h>
#include <cstdio>
#include <cstdint>
__device__ __forceinline__ float shx(float v, int k, int lane) { return __builtin_bit_cast(float, __builtin_amdgcn_ds_bpermute((lane ^ k) << 2, __builtin_bit_cast(int, v))); }
__device__ __forceinline__ float shl_(float v, int src, int lane) { (void)lane; return __builtin_bit_cast(float, __builtin_amdgcn_ds_bpermute(src << 2, __builtin_bit_cast(int, v))); }
namespace pg8 {
#define PG8_LAS __attribute__((address_space(3)))
typedef unsigned short bf16_t;
typedef short bf16x8 __attribute__((ext_vector_type(8)));
typedef float f32x4 __attribute__((ext_vector_type(4)));
typedef unsigned u32x4 __attribute__((ext_vector_type(4)));
constexpr int BM = 256, BK = 64, HALF = 128, HTB = HALF * BK * 2  , STAGE_BYTES = 8 * HTB, NXCD = 8, WGM = 8;

__host__ __device__ __forceinline__ int lds_byte(int r, int c) { const int st = (r >> 4) * 2 + (c >> 5), rr = r & 15, cc = c & 31, ob = rr * 64 + cc * 2; return st * 1024 + (ob ^ (((ob >> 9) & 1) << 5)); }
__host__ __device__ __forceinline__ void stage_rc(int b, int& R, int& C) { const int st = b / 1024, sb = b % 1024, swz = sb ^ (((sb >> 9) & 1) << 5); R = (st >> 1) * 16 + swz / 64; C = (st & 1) * 32 + (swz % 64) / 2; }
__host__ __device__ __forceinline__ int perm32(int rho) { const int n = rho >> 4, i = rho & 15; return 8 * (i >> 2) + 4 * n + (i & 3); }

struct Unit { int pm, pn; };
struct Gemm { const bf16_t* A; const bf16_t* Bt; int M, N, K; };

struct StaticOrder {
    int nM, nN, nwg, G, c;
    __host__ __device__ void init(int M, int N, int G_, int c_) { nM = M / BM; nN = N / BM; nwg = nM * nN; G = G_; c = c_; }
    __host__ __device__ bool next(int i, Unit& u) const {
        const long L = (long)i * G + c; if (L >= nwg) return false;
        int wgid = (int)L; { const int q = nwg / NXCD, r = nwg % NXCD, xcd = wgid % NXCD, off = wgid / NXCD; wgid = (xcd < r ? xcd * (q + 1) : r * (q + 1) + (xcd - r) * q) + off; }
        const int nig = WGM * nN, gid = wgid / nig, fm = gid * WGM, gsz = (nM - fm) < WGM ? (nM - fm) : WGM;
        u.pm = fm + ((wgid % nig) % gsz); u.pn = (wgid % nig) / gsz; return true;
    }
    __device__ __forceinline__ void a_ready(const Unit&) const {}
    __device__ __forceinline__ void done(const Unit&) const {}
};

__device__ __forceinline__ unsigned cvt_pk_bf16(float lo, float hi) { unsigned r; asm volatile("v_cvt_pk_bf16_f32 %0, %1, %2" : "=v"(r) : "v"(lo), "v"(hi)); return r; }
typedef float f32x2 __attribute__((ext_vector_type(2)));
typedef unsigned u32x2 __attribute__((ext_vector_type(2)));
constexpr float QC2 = 0.125f * 1.4426950408889634f;
constexpr int ZPITCH = 3072, SEQ_ = 16384;
__device__ __forceinline__ float row_rstd(const float* ssq, int row) {
    const f32x4 q = *(const f32x4*)(ssq + (size_t)row * 4); return 1.0f / sqrtf(((q[0] + q[1]) + (q[2] + q[3])) * (1.0f / 1024.0f) + 1e-5f);
}
struct EpiInProj {
    static constexpr bool PERM = true, AFTER_DRAIN = false;
    bf16_t* Z; const PG8_LAS float* rtab;     const float* ssq; const float* bf; float* logf2; unsigned* nrm;
    __device__ __forceinline__ void operator()(const f32x4 (&acc)[2][2][4][2], const Unit& u, int wr, int wc, int fr, int fq, int ui) const {
        const int row0 = u.pm * BM + wr * 64 + fr;
        float rs[2][4];
#pragma unroll
        for (int ai = 0; ai < 2; ++ai)
#pragma unroll
            for (int m = 0; m < 4; ++m) rs[ai][m] = rtab[ui * 256 + wr * 64 + fr + ai * HALF + m * 16];
        if (u.pn < 12) {
            const float sc = (u.pn < 2 || u.pn == 6 || u.pn == 7) ? QC2 : 1.f;
            const int col0 = u.pn * BM + wc * 32 + 8 * fq;
#pragma unroll
            for (int ai = 0; ai < 2; ++ai)
#pragma unroll
                for (int m = 0; m < 4; ++m) { bf16_t* rowp = Z + (size_t)(row0 + ai * HALF + m * 16) * ZPITCH + col0; const float s = rs[ai][m] * sc;
#pragma unroll
                    for (int bj = 0; bj < 2; ++bj) { const f32x4 v0 = acc[ai][bj][m][0] * s, v1 = acc[ai][bj][m][1] * s; u32x4 w;
                        w.x = cvt_pk_bf16(v0[0], v0[1]); w.y = cvt_pk_bf16(v0[2], v0[3]); w.z = cvt_pk_bf16(v1[0], v1[1]); w.w = cvt_pk_bf16(v1[2], v1[3]);
                        *(u32x4*)(rowp + bj * HALF) = w; } }
            if ((u.pn >= 2 && u.pn < 4) || (u.pn >= 6 && u.pn < 10)) {
                const int which = u.pn < 4 ? (u.pn >> 1) : 2 + ((u.pn - 6) >> 1);
                float mx[2] = {0.f, 0.f};
#pragma unroll
                for (int ai = 0; ai < 2; ++ai)
#pragma unroll
                    for (int m = 0; m < 4; ++m) { const float s = rs[ai][m] * sc;
#pragma unroll
                        for (int bj = 0; bj < 2; ++bj) { const f32x4 v0 = acc[ai][bj][m][0] * s, v1 = acc[ai][bj][m][1] * s;
                            float p = (v0[0] * v0[0] + v0[1] * v0[1]) + (v0[2] * v0[2] + v0[3] * v0[3]) + (v1[0] * v1[0] + v1[1] * v1[1]) + (v1[2] * v1[2] + v1[3] * v1[3]);
                            p += shx(p, 16, fr + 16 * fq); p += shx(p, 32, fr + 16 * fq); mx[bj] = fmaxf(mx[bj], p); } }
#pragma unroll
                for (int bj = 0; bj < 2; ++bj) { float m = mx[bj]; { const int ln = fr + 16 * fq; m = fmaxf(m, shx(m, 1, ln)); m = fmaxf(m, shx(m, 2, ln)); m = fmaxf(m, shx(m, 4, ln)); m = fmaxf(m, shx(m, 8, ln)); }
                    if (fr == 0 && fq == 0) atomicMax(nrm + (((which * 2 + (u.pm >> 6)) * 8 + (u.pn & 1) * 4 + bj * 2 + (wc >> 1)) * 2 + (wc & 1)), __float_as_uint(m)); }
            }
        } else if (wc == 0 && fq == 0) {
#pragma unroll
            for (int ai = 0; ai < 2; ++ai)
#pragma unroll
                for (int m = 0; m < 4; ++m) { const int row = row0 + ai * HALF + m * 16, b = row / SEQ_, s = row % SEQ_; const float r = rs[ai][m];
#pragma unroll
                    for (int j = 0; j < 8; ++j) { const float a = (j < 4) ? acc[ai][0][m][0][j & 3] : acc[ai][0][m][1][j & 3]; const float z = a * r + bf[j];
                        const float ls = fminf(z, 0.f) - log1pf(expf(-fabsf(z)));
                        logf2[(size_t)(b * 8 + j) * SEQ_ + s] = ls * 1.4426950408889634f; } }
        }
    }
};
struct EpiRelu2 {
    static constexpr bool PERM = true, AFTER_DRAIN = false;
    bf16_t* H; const PG8_LAS float* rtab;
    __device__ __forceinline__ void operator()(const f32x4 (&acc)[2][2][4][2], const Unit& u, int wr, int wc, int fr, int fq, int ui) const {
        const int row0 = u.pm * BM + wr * 64 + fr, col0 = u.pn * BM + wc * 32 + 8 * fq;
#pragma unroll
        for (int ai = 0; ai < 2; ++ai)
#pragma unroll
            for (int m = 0; m < 4; ++m) { const int row = row0 + ai * HALF + m * 16; const float s = rtab[ui * 256 + wr * 64 + fr + ai * HALF + m * 16]; bf16_t* rowp = H + (size_t)row * 4096 + col0;
#pragma unroll
                for (int bj = 0; bj < 2; ++bj) { f32x4 v0 = acc[ai][bj][m][0] * s, v1 = acc[ai][bj][m][1] * s;
#pragma unroll
                    for (int e = 0; e < 4; ++e) { const float a = fmaxf(v0[e], 0.f), b = fmaxf(v1[e], 0.f); v0[e] = a * a; v1[e] = b * b; }
                    u32x4 w; w.x = cvt_pk_bf16(v0[0], v0[1]); w.y = cvt_pk_bf16(v0[2], v0[3]); w.z = cvt_pk_bf16(v1[0], v1[1]); w.w = cvt_pk_bf16(v1[2], v1[3]);
                    *(u32x4*)(rowp + bj * HALF) = w; } }
    }
};
struct EpiResid {
    static constexpr bool PERM = false, AFTER_DRAIN = false;
    bf16_t* xb; float* ssq; PG8_LAS float* P;
    __device__ __forceinline__ void operator()(const f32x4 (&acc)[2][2][4][2], const Unit& u, int wr, int wc, int fr, int fq, int) const {
        const int col0 = u.pn * BM + wc * 32 + 4 * fq;
#pragma unroll
        for (int ai = 0; ai < 2; ++ai)
#pragma unroll
            for (int m = 0; m < 4; ++m) { const int r = ai * HALF + wr * 64 + m * 16 + fr; const size_t off = (size_t)(u.pm * BM + r) * 1024 + col0; float s = 0.f;
#pragma unroll
                for (int bj = 0; bj < 2; ++bj)
#pragma unroll
                    for (int n = 0; n < 2; ++n) { const u32x2 bw = *(const u32x2*)(xb + off + bj * HALF + n * 16);
                        const f32x4 b = {__builtin_bit_cast(float, bw.x << 16), __builtin_bit_cast(float, bw.x & 0xffff0000u), __builtin_bit_cast(float, bw.y << 16), __builtin_bit_cast(float, bw.y & 0xffff0000u)};
                        const f32x4 v = b + acc[ai][bj][m][n];
                        u32x2 w; w.x = cvt_pk_bf16(v[0], v[1]); w.y = cvt_pk_bf16(v[2], v[3]); *(u32x2*)(xb + off + bj * HALF + n * 16) = w;
                        s += (v[0] * v[0] + v[1] * v[1]) + (v[2] * v[2] + v[3] * v[3]); }
                s += shx(s, 16, fr + 16 * fq); s += shx(s, 32, fr + 16 * fq);
                if (fq == 0) P[r * 4 + wc] = s;
                if (m == 3) asm volatile("" ::: "memory"); }
        asm volatile("s_waitcnt lgkmcnt(0)\n\ts_barrier" ::: "memory");
        int tid = threadIdx.x; asm volatile("" : "+v"(tid));
        if (tid < 256) { const f32x4 p = *(const PG8_LAS f32x4*)(P + tid * 4); ssq[(size_t)(u.pm * BM + tid) * 4 + u.pn] = (p[0] + p[1]) + (p[2] + p[3]); }
        asm volatile("s_waitcnt lgkmcnt(0)" ::: "memory");
    }
};
template <class Epi, class Sched, bool ALIGN_EPI = false, bool SP2 = false>
__device__ __forceinline__ void gemm_phase(PG8_LAS unsigned char* lds, const Gemm g, const Sched& S, const Epi& E) {
    int tid_ = threadIdx.x; asm volatile("" : "+v"(tid_));
    const int tid = tid_, wid = __builtin_amdgcn_readfirstlane(tid >> 6), lane = tid & 63, wr = wid >> 2, wc = wid & 3, fr = lane & 15, fq = lane >> 4;
    const int K = g.K, nt = K / BK;
    unsigned voffA[2], voffB[2];
#pragma unroll
    for (int i = 0; i < 2; ++i) { int R, C; stage_rc(tid * 16 + i * 8192, R, C); const int Rb = Epi::PERM ? ((R & ~31) + perm32(R & 31)) : R;
        voffA[i] = (unsigned)(R * K + C) * 2u; voffB[i] = (unsigned)(Rb * K + C) * 2u; }
    const size_t kstep = (size_t)(BK * 2);
    const size_t hstep = (size_t)HALF * K * 2;
    const size_t tstep = 2 * hstep;
    const unsigned ldsw = (unsigned)wid * 1024u;
    const int aoff = lds_byte(wr * 64 + fr, fq * 8), boff = lds_byte(wc * 32 + fr, fq * 8);
#define PG8_SA(b, h) (((b) * 2 + (h)) * HTB)
#define PG8_SB(b, h) ((4 + (b) * 2 + (h)) * HTB)
#define PG8_STAGE(bufoff, gbase, voff) do { _Pragma("unroll") for (int _i = 0; _i < 2; ++_i) \
        __builtin_amdgcn_global_load_lds((const unsigned*)((const char*)(gbase) + (voff)[_i]), (PG8_LAS unsigned*)(lds + (bufoff) + ldsw + _i * 8192), 16, 0, 0); } while (0)
#define PG8_LDA(dst, b, h) do { _Pragma("unroll") for (int m = 0; m < 4; ++m) _Pragma("unroll") for (int k = 0; k < 2; ++k) dst[m][k] = *(const PG8_LAS bf16x8*)(lds + PG8_SA(b, h) + aoff + m * 2048 + k * 1024); } while (0)
#define PG8_LDB(dst, b, h) do { _Pragma("unroll") for (int n = 0; n < 2; ++n) _Pragma("unroll") for (int k = 0; k < 2; ++k) dst[n][k] = *(const PG8_LAS bf16x8*)(lds + PG8_SB(b, h) + boff + n * 2048 + k * 1024); } while (0)
#define PG8_MMA(ai, bj, At, Bt) do { __builtin_amdgcn_s_setprio(1); _Pragma("unroll") for (int m = 0; m < 4; ++m) _Pragma("unroll") for (int n = 0; n < 2; ++n) _Pragma("unroll") for (int k = 0; k < 2; ++k) \
        acc[ai][bj][m][n] = __builtin_amdgcn_mfma_f32_16x16x32_bf16(Bt[n][k], At[m][k], acc[ai][bj][m][n], 0, 0, 0); __builtin_amdgcn_s_setprio(0); } while (0)
#define PG8_WAIT_V(n) asm volatile("s_waitcnt vmcnt(" #n ")" ::: "memory")
#define PG8_WAIT_L(n) asm volatile("s_waitcnt lgkmcnt(" #n ")" ::: "memory")
#define PG8_BAR __builtin_amdgcn_s_barrier()
#define PG8_SCHED __builtin_amdgcn_sched_barrier(0)
    Unit cur, nxt; int ui = 0;
    if (!S.next(0, cur)) return;
    f32x4 acc[2][2][4][2];
#pragma unroll
    for (int a = 0; a < 2; ++a)
#pragma unroll
        for (int b = 0; b < 2; ++b)
#pragma unroll
            for (int m = 0; m < 4; ++m)
#pragma unroll
                for (int n = 0; n < 2; ++n) acc[a][b][m][n] = (f32x4){0.f, 0.f, 0.f, 0.f};
    bf16x8 At[4][2], B0[2][2], B1[2][2];
    const char* cA = (const char*)g.A + (size_t)cur.pm * tstep; const char* cB = (const char*)g.Bt + (size_t)cur.pn * tstep;
    S.a_ready(cur);
    if constexpr (SP2) {
        PG8_STAGE(PG8_SB(0, 0), cB, voffB); PG8_STAGE(PG8_SB(0, 1), cB + hstep, voffB); PG8_STAGE(PG8_SA(0, 0), cA, voffA); PG8_STAGE(PG8_SA(0, 1), cA + hstep, voffA);
        if (wr == 1) PG8_BAR;
        PG8_WAIT_V(2); PG8_BAR;
        PG8_STAGE(PG8_SB(1, 0), cB + kstep, voffB); PG8_STAGE(PG8_SA(1, 0), cA + kstep, voffA); PG8_STAGE(PG8_SB(1, 1), cB + hstep + kstep, voffB);
        PG8_WAIT_V(6); PG8_BAR;
    } else {
        PG8_STAGE(PG8_SB(0, 0), cB, voffB); PG8_STAGE(PG8_SA(0, 0), cA, voffA); PG8_STAGE(PG8_SB(0, 1), cB + hstep, voffB); PG8_STAGE(PG8_SA(0, 1), cA + hstep, voffA);
        if (wr == 1) PG8_BAR;
        PG8_WAIT_V(4); PG8_BAR;
        PG8_STAGE(PG8_SB(1, 0), cB + kstep, voffB); PG8_STAGE(PG8_SA(1, 0), cA + kstep, voffA); PG8_STAGE(PG8_SB(1, 1), cB + hstep + kstep, voffB);
        PG8_WAIT_V(6); PG8_BAR;
    }
    for (;;) {
        const bool has_next = S.next(ui + 1, nxt);
        const char* nA = has_next ? (const char*)g.A + (size_t)nxt.pm * tstep : cA; const char* nB = has_next ? (const char*)g.Bt + (size_t)nxt.pn * tstep : cB;
        for (int t = 0; t < nt; t += 2) {
            const bool last = (t == nt - 2);
            const char* a1 = cA + (size_t)(t + 1) * kstep;
            const char* a2 = last ? nA : cA + (size_t)(t + 2) * kstep; const char* b2 = last ? nB : cB + (size_t)(t + 2) * kstep;
            const char* a3 = a2 + kstep; const char* b3 = b2 + kstep;
            if (last && has_next) S.a_ready(nxt);
            if constexpr (SP2) {
            PG8_LDB(B0, 0, 0); PG8_LDB(B1, 0, 1); PG8_SCHED; PG8_LDA(At, 0, 0); PG8_STAGE(PG8_SA(1, 1), a1 + hstep, voffA);
            PG8_WAIT_V(8); PG8_WAIT_L(0); PG8_BAR; PG8_MMA(0, 0, At, B0); PG8_MMA(0, 1, At, B1); PG8_BAR; PG8_SCHED;
            PG8_LDA(At, 0, 1); PG8_STAGE(PG8_SB(0, 0), b2, voffB); PG8_STAGE(PG8_SB(0, 1), b2 + hstep, voffB); PG8_STAGE(PG8_SA(0, 0), a2, voffA);
            PG8_WAIT_V(8); PG8_WAIT_L(0); PG8_BAR; PG8_MMA(1, 0, At, B0); PG8_MMA(1, 1, At, B1); PG8_BAR; PG8_SCHED;
            PG8_LDB(B0, 1, 0); PG8_LDB(B1, 1, 1); PG8_SCHED; PG8_LDA(At, 1, 0); PG8_STAGE(PG8_SA(0, 1), a2 + hstep, voffA);
            PG8_WAIT_V(8); PG8_WAIT_L(0); PG8_BAR; PG8_MMA(0, 0, At, B0); PG8_MMA(0, 1, At, B1); PG8_BAR; PG8_SCHED;
            PG8_LDA(At, 1, 1); PG8_STAGE(PG8_SB(1, 0), b3, voffB); PG8_STAGE(PG8_SB(1, 1), b3 + hstep, voffB); PG8_STAGE(PG8_SA(1, 0), a3, voffA);
            PG8_WAIT_V(8); PG8_WAIT_L(0); PG8_BAR; PG8_MMA(1, 0, At, B0); PG8_MMA(1, 1, At, B1); PG8_BAR; PG8_SCHED;
            } else {
            PG8_LDB(B0, 0, 0); PG8_SCHED; PG8_LDA(At, 0, 0); PG8_STAGE(PG8_SA(1, 1), a1 + hstep, voffA);
            PG8_WAIT_L(8); PG8_BAR; PG8_WAIT_L(0); PG8_MMA(0, 0, At, B0); PG8_BAR; PG8_SCHED;
            PG8_LDB(B1, 0, 1); PG8_STAGE(PG8_SB(0, 0), b2, voffB);
            PG8_BAR; PG8_WAIT_L(0); PG8_MMA(0, 1, At, B1); PG8_BAR;
            PG8_LDA(At, 0, 1); PG8_STAGE(PG8_SA(0, 0), a2, voffA);
            PG8_BAR; PG8_WAIT_L(0); PG8_MMA(1, 0, At, B0); PG8_BAR; PG8_SCHED;
            PG8_STAGE(PG8_SB(0, 1), b2 + hstep, voffB);
            PG8_WAIT_V(6); PG8_BAR; PG8_MMA(1, 1, At, B1); PG8_BAR;
            PG8_LDB(B0, 1, 0); PG8_SCHED; PG8_LDA(At, 1, 0); PG8_STAGE(PG8_SA(0, 1), a2 + hstep, voffA);
            PG8_WAIT_L(8); PG8_BAR; PG8_WAIT_L(0); PG8_MMA(0, 0, At, B0); PG8_BAR; PG8_SCHED;
            PG8_LDB(B1, 1, 1); PG8_STAGE(PG8_SB(1, 0), b3, voffB);
            PG8_BAR; PG8_WAIT_L(0); PG8_MMA(0, 1, At, B1); PG8_BAR;
            PG8_LDA(At, 1, 1); PG8_STAGE(PG8_SA(1, 0), a3, voffA);
            PG8_BAR; PG8_WAIT_L(0); PG8_MMA(1, 0, At, B0); PG8_BAR; PG8_SCHED;
            PG8_STAGE(PG8_SB(1, 1), b3 + hstep, voffB);
            PG8_WAIT_V(6); PG8_BAR; PG8_MMA(1, 1, At, B1); PG8_BAR;
            }
        }
        if constexpr (ALIGN_EPI) { if (wr == 0) PG8_BAR; }
        if constexpr (!Epi::AFTER_DRAIN) { E(acc, cur, wr, wc, fr, fq, ui); S.done(cur); }
        if (!has_next) break;
#pragma unroll
        for (int a = 0; a < 2; ++a)
#pragma unroll
            for (int b = 0; b < 2; ++b)
#pragma unroll
                for (int m = 0; m < 4; ++m)
#pragma unroll
                    for (int n = 0; n < 2; ++n) acc[a][b][m][n] = (f32x4){0.f, 0.f, 0.f, 0.f};
        cur = nxt; cA = nA; cB = nB; ++ui;
        if constexpr (ALIGN_EPI) { if (wr == 1) PG8_BAR; }
    }
    PG8_WAIT_V(0);
    if constexpr (!ALIGN_EPI) { if (wr == 0) PG8_BAR; }
    PG8_BAR;
    if constexpr (Epi::AFTER_DRAIN) { E.fused(acc, cur, wr, wc, fr, fq, lds, wid, lane); S.done(cur); }
#undef PG8_SA
#undef PG8_SB
#undef PG8_STAGE
#undef PG8_LDA
#undef PG8_LDB
#undef PG8_MMA
#undef PG8_WAIT_V
#undef PG8_WAIT_L
#undef PG8_BAR
#undef PG8_SCHED
}
}
#include <hip/hip_bf16.h>
#include <cmath>
namespace attn_body {
using bf16=__hip_bfloat16;
using bf16x8=__attribute__((ext_vector_type(8)))short;
using s16x4=__attribute__((ext_vector_type(4)))short;
using f32x16=__attribute__((ext_vector_type(16)))float;
using u32x4=__attribute__((ext_vector_type(4)))unsigned;
constexpr int BATCH=2,SEQ=16384,D=64,ZP=3072,OP=1024;
constexpr int NW=8,QBLK=32,QB=QBLK*NW,KVBLK=64,NQB=SEQ/QB;
constexpr int ATTN_UNIT_ROWS=QB;
__device__ __forceinline__ int crow(int r,int hi){return (r&3)+8*(r>>2)+4*hi;}
#define SBAR() __builtin_amdgcn_sched_barrier(0)
__device__ __forceinline__ void cmask(f32x16&p0,f32x16&p1,int jb,int qrel,int hi){
  const float NEG=-INFINITY; int kb=64*jb+4*hi;
  #pragma unroll
  for(int r=0;r<16;++r){int kv=kb+(r&3)+8*(r>>2); if(kv>qrel)p0[r]=NEG; if(kv+32>qrel)p1[r]=NEG;}
}

constexpr int NSLOT=3, SLOTB=8192;
constexpr int LDS_K=0, LDS_V=NSLOT*SLOTB, LDS_WS=2*NSLOT*SLOTB, LDS_OST=LDS_WS+NW*64*4, LDS_BYTES=LDS_OST+NW*4096;
constexpr int LDS_EXTRA=LDS_BYTES, LDS_CS=LDS_EXTRA  , LDS_OST2=LDS_EXTRA  , LDS_TBL=LDS_EXTRA+NW*4096  , LDS_AUX=LDS_EXTRA+65536, LDS_TOTAL=LDS_AUX+256;
typedef __attribute__((address_space(3))) float ldsf; typedef __attribute__((address_space(3))) const float cldsf; typedef float f32x4a __attribute__((ext_vector_type(4)));
constexpr float LOG2E=1.4426950408889634f;
constexpr float C2=0.125f*1.4426950408889634f;
__device__ __forceinline__ void glds16(const void*gsrc,unsigned lds_dst){unsigned keep;
  asm volatile("s_mov_b32 %0, m0\n\ts_mov_b32 m0, %2\n\ts_nop 0\n\tglobal_load_lds_dwordx4 %1, off\n\ts_mov_b32 m0, %0":"=&s"(keep):"v"(gsrc),"s"(lds_dst):"memory");}
__device__ __forceinline__ void glds16s(const void*sbase,unsigned voff,unsigned lds_dst){unsigned keep;
  asm volatile("s_mov_b32 %0, m0\n\ts_mov_b32 m0, %3\n\ts_nop 0\n\tglobal_load_lds_dwordx4 %1, %2\n\ts_mov_b32 m0, %0":"=&s"(keep):"v"(voff),"s"(sbase),"s"(lds_dst):"memory");}
__device__ __forceinline__ void glds16s3(const void*kbase,unsigned koff,unsigned kdst,const void*vbase,unsigned voff,unsigned vdst){unsigned keep;
  asm volatile("s_mov_b32 %0, m0\n\ts_mov_b32 m0, %3\n\ts_nop 0\n\tglobal_load_lds_dwordx4 %1, %2\n\t"
               "s_mov_b32 m0, %6\n\ts_nop 0\n\tglobal_load_lds_dwordx4 %4, %5\n\t"
               "s_mov_b32 m0, %7\n\ts_nop 0\n\tglobal_load_lds_dwordx4 %4, %5 offset:128\n\ts_mov_b32 m0, %0"
               :"=&s"(keep):"v"(koff),"s"(kbase),"s"(kdst),"v"(voff),"s"(vbase),"s"(vdst),"s"(vdst+8192u-128u):"memory");}
__device__ __forceinline__ float max3f(float a,float b,float c){float r;asm("v_max3_f32 %0, %1, %2, %3":"=v"(r):"v"(a),"v"(b),"v"(c));return r;}
__device__ __forceinline__ float max2f(float a,float b){float r;asm("v_max_f32_e32 %0, %1, %2":"=v"(r):"v"(a),"v"(b));return r;}
__device__ __forceinline__ float fadd_s(float a,float b){float r;asm("v_add_f32_e32 %0, %1, %2":"=v"(r):"v"(a),"v"(b));return r;}
__device__ __forceinline__ float fsub_s(float a,float b){float r;asm("v_sub_f32_e32 %0, %1, %2":"=v"(r):"v"(a),"v"(b));return r;}
typedef float f32x2_t __attribute__((ext_vector_type(2))); typedef __bf16 bf16x2_t __attribute__((ext_vector_type(2)));
__device__ __forceinline__ unsigned cvtpk_s(float lo,float hi){f32x2_t v={lo,hi};bf16x2_t b=__builtin_convertvector(v,bf16x2_t);return __builtin_bit_cast(unsigned,b);}
#define WAIT_BAR(N) asm volatile("s_waitcnt vmcnt(" #N ") lgkmcnt(0)\n\ts_barrier":::"memory")

__device__ __forceinline__ void qkt(f32x16&p0,f32x16&p1,const char*Kslot,const bf16x8*qr,const f32x16&negm,int r32,int hi){
  const char*kb=Kslot+hi*1024+r32*16;
  #pragma unroll
  for(int d0=0;d0<4;++d0){
    const bf16x8 b0=*reinterpret_cast<const bf16x8*>(kb+d0*2048);
    const bf16x8 b1=*reinterpret_cast<const bf16x8*>(kb+d0*2048+512);
    if(d0==0){p0=__builtin_amdgcn_mfma_f32_32x32x16_bf16(b0,qr[0],negm,0,0,0);p1=__builtin_amdgcn_mfma_f32_32x32x16_bf16(b1,qr[0],negm,0,0,0);}
    else{p0=__builtin_amdgcn_mfma_f32_32x32x16_bf16(b0,qr[d0],p0,0,0,0);p1=__builtin_amdgcn_mfma_f32_32x32x16_bf16(b1,qr[d0],p1,0,0,0);}}
}
typedef __attribute__((address_space(3))) const char* lds_cptr;
typedef short v4i16_t __attribute__((ext_vector_type(4)));
__device__ __forceinline__ void kload8(bf16x8*kf,lds_cptr kp){
  kf[0]=*(const __attribute__((address_space(3))) bf16x8*)(kp);      kf[1]=*(const __attribute__((address_space(3))) bf16x8*)(kp+512);
  kf[2]=*(const __attribute__((address_space(3))) bf16x8*)(kp+2048); kf[3]=*(const __attribute__((address_space(3))) bf16x8*)(kp+2560);
  kf[4]=*(const __attribute__((address_space(3))) bf16x8*)(kp+4096); kf[5]=*(const __attribute__((address_space(3))) bf16x8*)(kp+4608);
  kf[6]=*(const __attribute__((address_space(3))) bf16x8*)(kp+6144); kf[7]=*(const __attribute__((address_space(3))) bf16x8*)(kp+6656);
}
__device__ __forceinline__ void kload2(bf16x8*kf,lds_cptr kp,int j){ kf[2*j]=*(const __attribute__((address_space(3))) bf16x8*)(kp+j*2048); kf[2*j+1]=*(const __attribute__((address_space(3))) bf16x8*)(kp+j*2048+512); }
__device__ __forceinline__ s16x4 vtr(lds_cptr p){ return __builtin_bit_cast(s16x4,__builtin_amdgcn_ds_read_tr16_b64_v4i16((__attribute__((address_space(3))) v4i16_t*)p)); }
__device__ __forceinline__ float rowmax(const f32x16&p0,const f32x16&p1){
  float a=max3f(p0[0],p0[1],p1[0]),b=max3f(p0[2],p0[3],p1[1]);a=max3f(a,p1[2],p1[3]);
  #pragma unroll
  for(int r=4;r<16;r+=4){a=max3f(a,p0[r],p0[r+1]);b=max3f(b,p0[r+2],p0[r+3]);a=max3f(a,p1[r],p1[r+1]);b=max3f(b,p1[r+2],p1[r+3]);}
  const float m=max2f(a,b);
  auto rr=__builtin_amdgcn_permlane32_swap(__float_as_uint(m),__float_as_uint(m),false,false);
  return max2f(__uint_as_float(rr[0]),__uint_as_float(rr[1]));
}
__device__ __forceinline__ void pv(f32x16*o,int vb,bf16x8 pa0,bf16x8 pa1,bf16x8 pa2,bf16x8 pa3){
  #pragma unroll
  for(int d0=0;d0<2;++d0){s16x4 lo[4],hi[4];
    #pragma unroll
    for(int ks=0;ks<4;++ks){
      asm volatile("ds_read_b64_tr_b16 %0,%1 offset:%c2":"=&v"(lo[ks]):"v"(vb),"i"(d0*4096+ks*1024):"memory");
      asm volatile("ds_read_b64_tr_b16 %0,%1 offset:%c2":"=&v"(hi[ks]):"v"(vb),"i"(d0*4096+ks*1024+512):"memory");}
    asm volatile("s_waitcnt lgkmcnt(0)":::"memory");SBAR();
    #define PK(k) (bf16x8){lo[k][0],lo[k][1],lo[k][2],lo[k][3],hi[k][0],hi[k][1],hi[k][2],hi[k][3]}
    o[d0]=__builtin_amdgcn_mfma_f32_32x32x16_bf16(pa0,PK(0),o[d0],0,0,0);
    o[d0]=__builtin_amdgcn_mfma_f32_32x32x16_bf16(pa1,PK(1),o[d0],0,0,0);
    o[d0]=__builtin_amdgcn_mfma_f32_32x32x16_bf16(pa2,PK(2),o[d0],0,0,0);
    o[d0]=__builtin_amdgcn_mfma_f32_32x32x16_bf16(pa3,PK(3),o[d0],0,0,0);
    #undef PK
  }
}


__device__ __forceinline__ void subcs(f32x16&p0,f32x16&p1,cldsf*c,float mh){
  #pragma unroll
  for(int g=0;g<4;++g){ const f32x4a a=*(const __attribute__((address_space(3))) f32x4a*)(c+8*g)+mh, b4=*(const __attribute__((address_space(3))) f32x4a*)(c+32+8*g)+mh;
    #pragma unroll
    for(int i=0;i<4;++i){p0[4*g+i]-=a[i];p1[4*g+i]-=b4[i];}
    if(g==1)SBAR(); }
}
__device__ __forceinline__ void submh(f32x16&p0,f32x16&p1,float mh){
  #pragma unroll
  for(int r=0;r<16;++r){p0[r]-=mh;p1[r]-=mh;}
}
__device__ __forceinline__ void dbias(f32x16&p0,f32x16&p1,int jb,int wid,int r32,int hi,cldsf*tbl){
  if(jb>(wid>>1)){
    #pragma unroll
    for(int r=0;r<16;++r){p0[r]=-INFINITY;p1[r]=-INFINITY;}
  } else {
    cldsf*tp=tbl+(447+64*jb-(32*wid+r32)+4*hi);
    #pragma unroll
    for(int g=0;g<4;++g){
      #pragma unroll
      for(int i=0;i<4;++i){p0[4*g+i]+=tp[8*g+i];p1[4*g+i]+=tp[32+8*g+i];}}
  }
}
#ifndef ATTN_STORE16
#define ATTN_STORE16(p,v) (*(u32x4*)(p)=(v))
#endif
template<int MODE,int THRL,bool NOMAX> __device__ __forceinline__ void attn_unit(int qb,int kt0,const bf16*Qh,const bf16*__restrict__ Kh0,const bf16*__restrict__ Vh0,bf16*Oh,char*shm,int EPI,int stgoff,float lam){
  const bf16*Kh=Kh0+(long)kt0*KVBLK*ZP,*Vh=Vh0+(long)kt0*KVBLK*ZP;
  int tid_=threadIdx.x; asm volatile("":"+v"(tid_)); const int tid=tid_,lane=tid&63,r32=lane&31,hi=lane>>5; const int wid=__builtin_amdgcn_readfirstlane(tid>>6);
  const int q0=qb*QB;
  const bf16*Qw=Qh+(long)(q0+wid*QBLK)*ZP;
  cldsf*csl=(cldsf*)(lds_cptr)shm+LDS_CS/4+64*kt0; cldsf*tbl=(cldsf*)(lds_cptr)shm+LDS_TBL/4; (void)csl;(void)tbl;
  const unsigned lds0=(unsigned)(uintptr_t)shm;
  float*wsf=(float*)(shm+LDS_WS)+wid*64;
  const unsigned koff=(unsigned)(lane*ZP+wid*8)*2u;
  const unsigned voff=(unsigned)((16*(wid&3)+(lane>>2))*ZP+(wid>>2)*32+(lane&3)*8)*2u;
  const unsigned kdst=lds0+LDS_K+wid*1024, vdst=lds0+LDS_V+wid*1024;
  #define DMA_K(t,slot) glds16s(Kh+(long)(t)*KVBLK*ZP,koff,(unsigned)__builtin_amdgcn_readfirstlane(kdst+(slot)))
  #define DMA_V(t,slot) glds16s(Vh+(long)(t)*KVBLK*ZP,voff,(unsigned)__builtin_amdgcn_readfirstlane(vdst+(slot)))
  const int vb0=(int)(lds0+LDS_V)+((lane>>4)&1)*32+(lane&3)*8+(4*hi+((lane&15)>>2))*64;
  const char*Kbase=shm+LDS_K; bf16x8 kf[8];
  const lds_cptr shm3=(lds_cptr)shm; const lds_cptr kp0=shm3+LDS_K+hi*1024+r32*16; const lds_cptr vp0=shm3+LDS_V+((lane>>4)&1)*32+(lane&3)*8+(4*hi+((lane&15)>>2))*64;
  const int NT=(q0+QB)/KVBLK-kt0;
  DMA_K(0,0);DMA_V(0,0);DMA_K(1,SLOTB);
  bf16x8 qr[4];
  #pragma unroll
  for(int d0=0;d0<4;++d0)qr[d0]=*reinterpret_cast<const bf16x8*>(&Qw[(long)r32*ZP+d0*16+hi*8]);
  float mhat=0.f,l_reg=0.f;f32x16 o[2];o[0]=f32x16{};o[1]=f32x16{};f32x16 negm=f32x16{}; if(MODE==1){asm volatile("":"+v"(negm));}
  if(NOMAX){ mhat=-((cldsf*)(lds_cptr)shm+LDS_CS/4)[q0+wid*QBLK+r32]; }
  const int qrel=wid*QBLK+r32;
  #define CMASK(P0,P1,t) do{ const int jb_=(t)-(NT-4); if(MODE==0){ subcs(P0,P1,csl+64*(t)+4*hi,mhat); if(jb_>=0)cmask(P0,P1,jb_,qrel,hi); } else { if(jb_>=-3)dbias(P0,P1,jb_,wid,r32,hi,tbl); } }while(0)
  bool resc=false;
  #define START(P0,P1) do{ resc=false; if(!NOMAX) \
    { const float rm=rowmax(P0,P1); const float dl=rm; mhat=fadd_s(mhat,dl); \
      _Pragma("unroll") for(int r=0;r<16;++r){P0[r]=fsub_s(P0[r],dl);P1[r]=fsub_s(P1[r],dl);} \
      if(MODE==1){ _Pragma("unroll") for(int r=0;r<16;++r)negm[r]=-mhat; asm volatile("":"+v"(negm)); } } \
    _Pragma("unroll") for(int r=0;r<16;++r)P0[r]=__builtin_amdgcn_exp2f(P0[r]); }while(0)
  #define RESC() do{ if(resc){ asm volatile("s_waitcnt lgkmcnt(0)":::"memory"); \
      _Pragma("unroll") for(int d_=0;d_<2;++d_) _Pragma("unroll") for(int r=0;r<16;++r)o[d_][r]*=wsf[crow(r,hi)]; } }while(0)
  f32x16 pA0,pA1,pB0,pB1;
  int sl_prev=0,sl_cur=0,sl_next=SLOTB;
  #define ROT() do{sl_prev=sl_cur;sl_cur=sl_next;sl_next=(sl_next==(NSLOT-1)*SLOTB)?0:sl_next+SLOTB;}while(0)
  DMA_K(2,2*SLOTB);
  WAIT_BAR(3);
  qkt(pA0,pA1,Kbase,qr,negm,r32,hi);asm volatile("s_nop 15\n\ts_nop 7":"+v"(pA0),"+v"(pA1));CMASK(pA0,pA1,0);
  START(pA0,pA1);
  _Pragma("unroll") for(int r=0;r<16;++r)pA1[r]=__builtin_amdgcn_exp2f(pA1[r]);
  WAIT_BAR(0);
  DMA_K(3,0);DMA_V(1,SLOTB);
  ROT();
  kload8(kf,kp0+sl_cur);
  WAIT_BAR(2);
  s16x4 vlo[8],vhi[8]; u32x4 pw0,pw1,pw2,pw3;
  #define PKW(P,B) cvtpk_s(P[B],P[B+1])
  #define PAF(k) __builtin_bit_cast(bf16x8,pw##k)
  #define VFR(i) (bf16x8){vlo[i][0],vlo[i][1],vlo[i][2],vlo[i][3],vhi[i][0],vhi[i][1],vhi[i][2],vhi[i][3]}
  #define PIN(x) asm volatile("":"+v"(x))
  #define MX3(a,b,c) __builtin_fmaxf(__builtin_fmaxf((a),(b)),(c))
  #define GAPA(MF,A0,A1,A2,A3,W0,W1,PW) do{ MF; sacc+=A0; sacc+=A1; sacc+=A2; sacc+=A3; PIN(sacc); W0; W1; PIN(PW); SBAR(); }while(0)
  #define EX(v) __builtin_amdgcn_exp2f(v)
  #define GAPB(MF,X,B) do{ MF; X[B]=EX(X[B]); X[B+1]=EX(X[B+1]); X[B+2]=EX(X[B+2]); X[B+3]=EX(X[B+3]); PIN(X); SBAR(); }while(0)
  #define VRD(i) do{ vlo[i]=vtr(vp_+(((i)>>2)*4096+((i)&3)*1024)); vhi[i]=vtr(vp_+(((i)>>2)*4096+((i)&3)*1024+512)); }while(0)
  #define KRD(G,j) do{ if(G){ kload2(kf,kp0+sl_next,j); SBAR(); } }while(0)
  #define STEP(C0,C1,P0,P1,t,GK,GV,GL) do{ SBAR(); \
    const lds_cptr vp_=vp0+sl_prev; \
    VRD(0); SBAR(); float sacc=(P0[0]+P0[1]); \
    GAPA(C0=__builtin_amdgcn_mfma_f32_32x32x16_bf16(kf[0],qr[0],negm,0,0,0), P0[2],P0[3],P0[4],P0[5],     pw0[0]=PKW(P0,0), pw0[1]=PKW(P0,2), pw0); \
    VRD(4); SBAR(); GAPA(C1=__builtin_amdgcn_mfma_f32_32x32x16_bf16(kf[1],qr[0],negm,0,0,0), P0[6],P0[7],P0[8],P0[9],     pw0[2]=PKW(P0,4), pw0[3]=PKW(P0,6), pw0); \
    VRD(1); SBAR(); GAPA(C0=__builtin_amdgcn_mfma_f32_32x32x16_bf16(kf[2],qr[1],C0,0,0,0),   P0[10],P0[11],P0[12],P0[13], pw1[0]=PKW(P0,8), pw1[1]=PKW(P0,10), pw1); \
    VRD(5); SBAR(); GAPA(C1=__builtin_amdgcn_mfma_f32_32x32x16_bf16(kf[3],qr[1],C1,0,0,0),   P0[14],P0[15],P1[0],P1[1],   pw1[2]=PKW(P0,12),pw1[3]=PKW(P0,14), pw1); \
    VRD(2); SBAR(); GAPA(C0=__builtin_amdgcn_mfma_f32_32x32x16_bf16(kf[4],qr[2],C0,0,0,0),   P1[2],P1[3],P1[4],P1[5],     pw2[0]=PKW(P1,0), pw2[1]=PKW(P1,2), pw2); \
    VRD(6); SBAR(); GAPA(C1=__builtin_amdgcn_mfma_f32_32x32x16_bf16(kf[5],qr[2],C1,0,0,0),   P1[6],P1[7],P1[8],P1[9],     pw2[2]=PKW(P1,4), pw2[3]=PKW(P1,6), pw2); \
    VRD(3); SBAR(); GAPA(C0=__builtin_amdgcn_mfma_f32_32x32x16_bf16(kf[6],qr[3],C0,0,0,0),   P1[10],P1[11],P1[12],P1[13], pw3[0]=PKW(P1,8), pw3[1]=PKW(P1,10), pw3); \
    VRD(7); SBAR(); GAPA(C1=__builtin_amdgcn_mfma_f32_32x32x16_bf16(kf[7],qr[3],C1,0,0,0),   P1[14],P1[15],0.f,0.f,       pw3[2]=PKW(P1,12),pw3[3]=PKW(P1,14), pw3); \
    l_reg+=sacc; \
    if(GK){DMA_K((t)+3,sl_cur);} if(GV){DMA_V((t)+1,sl_next);} \
    CMASK(C0,C1,t); \
    if(!NOMAX){ float a=MX3(C0[0],C0[1],C1[0]),b=MX3(C0[2],C0[3],C1[1]); a=MX3(a,C1[2],C1[3]); \
      _Pragma("unroll") for(int r=4;r<16;r+=4){a=MX3(a,C0[r],C0[r+1]);b=MX3(b,C0[r+2],C0[r+3]);a=MX3(a,C1[r],C1[r+1]);b=MX3(b,C1[r+2],C1[r+3]);} \
      float rm=__builtin_fmaxf(a,b); { auto rr=__builtin_amdgcn_permlane32_swap(__float_as_uint(rm),__float_as_uint(rm),false,false); rm=__builtin_fmaxf(__uint_as_float(rr[0]),__uint_as_float(rr[1])); } \
      resc=false; \
      if(__builtin_expect(__any(rm>(float)THRL),0)){ const float dl=__builtin_fmaxf(rm,0.f); mhat+=dl; \
        _Pragma("unroll") for(int r=0;r<16;++r){C0[r]-=dl;C1[r]-=dl;} \
        if(MODE==1){ _Pragma("unroll") for(int r=0;r<16;++r)negm[r]=-mhat; asm volatile("":"+v"(negm)); } \
        const float f=__builtin_amdgcn_exp2f(-dl); l_reg*=f; if(hi==0)wsf[r32]=f; resc=true; } } \
    SBAR(); \
    GAPB(o[0]=__builtin_amdgcn_mfma_f32_32x32x16_bf16(PAF(0),VFR(0),o[0],0,0,0), C0,0); \
    GAPB(o[1]=__builtin_amdgcn_mfma_f32_32x32x16_bf16(PAF(0),VFR(4),o[1],0,0,0), C0,4); \
    KRD(GL,0); GAPB(o[0]=__builtin_amdgcn_mfma_f32_32x32x16_bf16(PAF(1),VFR(1),o[0],0,0,0), C0,8); \
    KRD(GL,1); GAPB(o[1]=__builtin_amdgcn_mfma_f32_32x32x16_bf16(PAF(1),VFR(5),o[1],0,0,0), C0,12); \
    KRD(GL,2); GAPB(o[0]=__builtin_amdgcn_mfma_f32_32x32x16_bf16(PAF(2),VFR(2),o[0],0,0,0), C1,0); \
    KRD(GL,3); GAPB(o[1]=__builtin_amdgcn_mfma_f32_32x32x16_bf16(PAF(2),VFR(6),o[1],0,0,0), C1,4); \
    GAPB(o[0]=__builtin_amdgcn_mfma_f32_32x32x16_bf16(PAF(3),VFR(3),o[0],0,0,0), C1,8); \
    GAPB(o[1]=__builtin_amdgcn_mfma_f32_32x32x16_bf16(PAF(3),VFR(7),o[1],0,0,0), C1,12); \
    }while(0)
  int t=1;
  #undef CMASK
  #define CMASK(P0,P1,t) do{ if(MODE==0){ subcs(P0,P1,csl+64*(t)+4*hi,mhat); } }while(0)
  for(;t+7<NT;t+=2){
    STEP(pB0,pB1,pA0,pA1,t,true,true,true);     WAIT_BAR(2); RESC(); ROT();
    STEP(pA0,pA1,pB0,pB1,t+1,true,true,true);   WAIT_BAR(2); RESC(); ROT();
  }
  #undef CMASK
  #define CMASK(P0,P1,t) do{ const int jb_=(t)-(NT-4); if(MODE==0){ subcs(P0,P1,csl+64*(t)+4*hi,mhat); if(jb_>=0)cmask(P0,P1,jb_,qrel,hi); } else { if(jb_>=-3)dbias(P0,P1,jb_,wid,r32,hi,tbl); } }while(0)
  #define ENDW(tt) do{ if((tt)+3<NT){WAIT_BAR(2);} else if((tt)+2<NT){WAIT_BAR(1);} else {WAIT_BAR(0);} }while(0)
  for(;t+1<NT;t+=2){
    STEP(pB0,pB1,pA0,pA1,t,(t+3<NT),(t+1<NT),(t+1<NT));       ENDW(t);   RESC(); ROT();
    STEP(pA0,pA1,pB0,pB1,t+1,(t+4<NT),(t+2<NT),(t+2<NT));     ENDW(t+1); RESC(); ROT();
  }
  STEP(pB0,pB1,pA0,pA1,NT-1,false,false,false); RESC();
  { float sacc=pB0[0]+pB0[1]; _Pragma("unroll") for(int r=2;r<16;++r)sacc+=pB0[r]; _Pragma("unroll") for(int r=0;r<16;++r)sacc+=pB1[r]; l_reg+=sacc;
    pw0=(u32x4){PKW(pB0,0),PKW(pB0,2),PKW(pB0,4),PKW(pB0,6)};pw1=(u32x4){PKW(pB0,8),PKW(pB0,10),PKW(pB0,12),PKW(pB0,14)};pw2=(u32x4){PKW(pB1,0),PKW(pB1,2),PKW(pB1,4),PKW(pB1,6)};pw3=(u32x4){PKW(pB1,8),PKW(pB1,10),PKW(pB1,12),PKW(pB1,14)};
    SBAR(); pv(o,vb0+sl_cur,PAF(0),PAF(1),PAF(2),PAF(3)); }
  #undef PKW
  #undef PAF
  #undef VFR
  #undef PIN
  #undef MX3
  #undef GAPA
  #undef GAPB
  #undef EX
  #undef VRD
  #undef KRD
  #undef STEP
  #undef ENDW
  {auto rr=__builtin_amdgcn_permlane32_swap(__float_as_uint(l_reg),__float_as_uint(l_reg),false,false);l_reg=__uint_as_float(rr[0])+__uint_as_float(rr[1]);}
  if(hi==0)wsf[32+r32]=l_reg;asm volatile("s_waitcnt lgkmcnt(0)":::"memory");
  float rli[16];
  #pragma unroll
  for(int r=0;r<16;++r)rli[r]=__builtin_amdgcn_rcpf(wsf[32+crow(r,hi)]);
  { bf16*stg=(bf16*)(shm+stgoff)+wid*2048;
    #pragma unroll
    for(int r=0;r<16;++r){const int orow=crow(r,hi);
      #pragma unroll
      for(int d0=0;d0<2;++d0){ float val=o[d0][r]*rli[r];
        if(EPI==2){ val=__bfloat162float(stg[orow*64+d0*32+r32])-lam*val; }
        stg[orow*64+d0*32+r32]=__float2bfloat16(val);}}
    asm volatile("s_waitcnt lgkmcnt(0)":::"memory");
    if(EPI==0){ bf16*Ow=Oh+(long)(q0+wid*QBLK)*OP;
      #pragma unroll
      for(int i=0;i<4;++i){const int row=i*8+(lane>>3),ch=lane&7; const u32x4 v=*(const u32x4*)(stg+row*64+ch*8); ATTN_STORE16(Ow+(long)row*OP+ch*8,v);} } }
  asm volatile("s_waitcnt lgkmcnt(0)\n\ts_barrier":::"memory");
  #undef DMA_K
  #undef DMA_V
  #undef CMASK
  #undef START
  #undef RESC
  #undef ROT
}
constexpr int D2_K=0, D2_V=NSLOT*SLOTB, D2_WS=D2_V+NSLOT*2*SLOTB, D2_OST=D2_WS+NW*64*4, D2_TBL=D2_OST+NW*8192, D2_END=D2_TBL+2048;
static_assert(D2_END<=LDS_AUX,"diff unit LDS map");
template<int THRL,bool NOMAX> __device__ __forceinline__ void attn_unit2(int qb,const bf16*Qh,const bf16*__restrict__ Kh,const bf16*__restrict__ Vh,char*shm,int EPI,float lam){
  constexpr int MODE=1;
  int tid_=threadIdx.x; asm volatile("":"+v"(tid_)); const int tid=tid_,lane=tid&63,r32=lane&31,hi=lane>>5; const int wid=__builtin_amdgcn_readfirstlane(tid>>6);
  const int q0=qb*QB;
  const bf16*Qw=Qh+(long)(q0+wid*QBLK)*ZP;
  cldsf*csl=nullptr; cldsf*tbl=(cldsf*)(lds_cptr)shm+D2_TBL/4; (void)csl;(void)tbl;
  const unsigned lds0=(unsigned)(uintptr_t)shm;
  float*wsf=(float*)(shm+D2_WS)+wid*64;
  const unsigned koff=(unsigned)(lane*ZP+wid*8)*2u;
  const unsigned voff=(unsigned)((16*(wid&3)+(lane>>2))*ZP+(wid>>2)*32+(lane&3)*8)*2u;
  const unsigned kdst=lds0+D2_K+wid*1024, vdst=lds0+D2_V+wid*1024;
  #define DMA_K(t,slot) glds16s(Kh+(long)(t)*KVBLK*ZP,koff,(unsigned)__builtin_amdgcn_readfirstlane(kdst+(slot)))
  #define DMA_V(t,slot) do{ glds16s(Vh+(long)(t)*KVBLK*ZP,voff,(unsigned)__builtin_amdgcn_readfirstlane(vdst+2*(slot))); glds16s(Vh+(long)(t)*KVBLK*ZP+64,voff,(unsigned)__builtin_amdgcn_readfirstlane(vdst+2*(slot)+8192)); }while(0)
  const int vb0=(int)(lds0+D2_V)+((lane>>4)&1)*32+(lane&3)*8+(4*hi+((lane&15)>>2))*64;
  const char*Kbase=shm+D2_K; bf16x8 kf[8];
  const lds_cptr shm3=(lds_cptr)shm; const lds_cptr kp0=shm3+D2_K+hi*1024+r32*16; const lds_cptr vp0=shm3+D2_V+((lane>>4)&1)*32+(lane&3)*8+(4*hi+((lane&15)>>2))*64;
  const int NT=(q0+QB)/KVBLK;
  DMA_K(0,0);DMA_V(0,0);DMA_K(1,SLOTB);
  bf16x8 qr[4];
  #pragma unroll
  for(int d0=0;d0<4;++d0)qr[d0]=*reinterpret_cast<const bf16x8*>(&Qw[(long)r32*ZP+d0*16+hi*8]);
  float mhat=0.f,l_reg=0.f;f32x16 o[4];o[0]=f32x16{};o[1]=f32x16{};o[2]=f32x16{};o[3]=f32x16{};
  const f32x16 zc=f32x16{};
  #define FIX(C0,C1,t) do{ const int jb_=(t)-(NT-4); submh(C0,C1,mhat); if(jb_>=-3)dbias(C0,C1,jb_,wid,r32,hi,tbl); }while(0)
  bool resc=false;
  #define RESC() do{ if(resc){ asm volatile("s_waitcnt lgkmcnt(0)":::"memory"); \
      _Pragma("unroll") for(int d_=0;d_<4;++d_) _Pragma("unroll") for(int r=0;r<16;++r)o[d_][r]*=wsf[crow(r,hi)]; } }while(0)
  f32x16 c0,c1;
  u32x4 pa0,pa1,pa2,pa3,pb0,pb1,pb2,pb3;
  int sl_prev=0,sl_cur=0,sl_next=SLOTB;
  #define ROT() do{sl_prev=sl_cur;sl_cur=sl_next;sl_next=(sl_next==(NSLOT-1)*SLOTB)?0:sl_next+SLOTB;}while(0)
  DMA_K(2,2*SLOTB);
  WAIT_BAR(3);
  #define EX(v) __builtin_amdgcn_exp2f(v)
  #define PKW(P,B) cvtpk_s(P[B],P[B+1])
  #define PIN(x) asm volatile("":"+v"(x))
  qkt(c0,c1,Kbase,qr,zc,r32,hi);asm volatile("s_nop 15\n\ts_nop 7":"+v"(c0),"+v"(c1));
  { const int jb_=0-(NT-4); if(jb_>=-3)dbias(c0,c1,jb_,wid,r32,hi,tbl); }
  { const float rm=NOMAX?0.f:rowmax(c0,c1); mhat=rm;
    _Pragma("unroll") for(int r=0;r<16;++r){c0[r]=EX(c0[r]-rm);c1[r]=EX(c1[r]-rm);}
    float sacc=0.f; _Pragma("unroll") for(int r=0;r<16;++r){sacc+=c0[r];} _Pragma("unroll") for(int r=0;r<16;++r){sacc+=c1[r];} l_reg=sacc;
    pa0=(u32x4){PKW(c0,0),PKW(c0,2),PKW(c0,4),PKW(c0,6)};pa1=(u32x4){PKW(c0,8),PKW(c0,10),PKW(c0,12),PKW(c0,14)};pa2=(u32x4){PKW(c1,0),PKW(c1,2),PKW(c1,4),PKW(c1,6)};pa3=(u32x4){PKW(c1,8),PKW(c1,10),PKW(c1,12),PKW(c1,14)}; }
  WAIT_BAR(0);
  DMA_K(3,0);DMA_V(1,SLOTB);
  ROT();
  kload8(kf,kp0+sl_cur);
  WAIT_BAR(3);
  s16x4 vlo[8],vhi[8];
  #define PAF(S,k) __builtin_bit_cast(bf16x8,S##k)
  #define VFR(i) (bf16x8){vlo[i][0],vlo[i][1],vlo[i][2],vlo[i][3],vhi[i][0],vhi[i][1],vhi[i][2],vhi[i][3]}
  #define MX3(a,b,c) __builtin_fmaxf(__builtin_fmaxf((a),(b)),(c))
  #define VRD(i) do{ vlo[i]=vtr(vp_+(((i)>>2)*4096+((i)&3)*1024)); vhi[i]=vtr(vp_+(((i)>>2)*4096+((i)&3)*1024+512)); }while(0)
  #define VRDB(i) do{ vlo[i]=vtr(vp_+(8192+((i)>>2)*4096+((i)&3)*1024)); vhi[i]=vtr(vp_+(8192+((i)>>2)*4096+((i)&3)*1024+512)); SBAR(); }while(0)
  #define KRD(G,j) do{ if(G){ kload2(kf,kp0+sl_next,j); SBAR(); } }while(0)
  #define GAPA(MF) do{ MF; SBAR(); }while(0)
  #define GAPB(MF,X,B,DV,DI) do{ MF; X[B]=EX(X[B]); X[B+1]=EX(X[B+1]); sacc+=X[B]; sacc+=X[B+1]; DV[DI]=cvtpk_s(X[B],X[B+1]); PIN(sacc); PIN(DV); SBAR(); }while(0)
  #define GAPB4(MF,X,B,DV,DI) do{ MF; X[B]=EX(X[B]); X[B+1]=EX(X[B+1]); X[B+2]=EX(X[B+2]); X[B+3]=EX(X[B+3]); sacc+=X[B]; sacc+=X[B+1]; sacc+=X[B+2]; sacc+=X[B+3]; DV[DI]=cvtpk_s(X[B],X[B+1]); DV[DI+1]=cvtpk_s(X[B+2],X[B+3]); PIN(sacc); PIN(DV); SBAR(); }while(0)
  #define STEP(SP,SN,t,GK,GV,GL) do{ SBAR(); \
    const lds_cptr vp_=vp0+2*sl_prev; \
    VRD(0); SBAR(); GAPA(c0=__builtin_amdgcn_mfma_f32_32x32x16_bf16(kf[0],qr[0],zc,0,0,0)); \
    VRD(4); SBAR(); GAPA(c1=__builtin_amdgcn_mfma_f32_32x32x16_bf16(kf[1],qr[0],zc,0,0,0)); \
    VRD(1); SBAR(); GAPA(c0=__builtin_amdgcn_mfma_f32_32x32x16_bf16(kf[2],qr[1],c0,0,0,0)); \
    VRD(5); SBAR(); GAPA(c1=__builtin_amdgcn_mfma_f32_32x32x16_bf16(kf[3],qr[1],c1,0,0,0)); \
    VRD(2); SBAR(); GAPA(c0=__builtin_amdgcn_mfma_f32_32x32x16_bf16(kf[4],qr[2],c0,0,0,0)); \
    VRD(6); SBAR(); GAPA(c1=__builtin_amdgcn_mfma_f32_32x32x16_bf16(kf[5],qr[2],c1,0,0,0)); \
    VRD(3); SBAR(); GAPA(c0=__builtin_amdgcn_mfma_f32_32x32x16_bf16(kf[6],qr[3],c0,0,0,0)); \
    VRD(7); SBAR(); GAPA(c1=__builtin_amdgcn_mfma_f32_32x32x16_bf16(kf[7],qr[3],c1,0,0,0)); \
    if(__builtin_constant_p(GK)&&(GK)&&(GV)){ glds16s3(Kh+(long)((t)+3)*KVBLK*ZP,koff,(unsigned)__builtin_amdgcn_readfirstlane(kdst+sl_cur),Vh+(long)((t)+1)*KVBLK*ZP,voff,(unsigned)__builtin_amdgcn_readfirstlane(vdst+2*sl_next)); } \
    else { if(GK){DMA_K((t)+3,sl_cur);} if(GV){DMA_V((t)+1,sl_next);} } \
    { const int jb_=(t)-(NT-4); if(jb_>=-3)dbias(c0,c1,jb_,wid,r32,hi,tbl); } \
    if constexpr(NOMAX){ SBAR(); float sacc=0.f; \
      GAPB(o[0]=__builtin_amdgcn_mfma_f32_32x32x16_bf16(PAF(SP,0),VFR(0),o[0],0,0,0), c0,0,SN##0,0); VRDB(0); \
      GAPB(o[1]=__builtin_amdgcn_mfma_f32_32x32x16_bf16(PAF(SP,0),VFR(4),o[1],0,0,0), c0,2,SN##0,1); VRDB(4); \
      KRD(GL,0); GAPB(o[0]=__builtin_amdgcn_mfma_f32_32x32x16_bf16(PAF(SP,1),VFR(1),o[0],0,0,0), c0,4,SN##0,2); VRDB(1); \
      KRD(GL,1); GAPB(o[1]=__builtin_amdgcn_mfma_f32_32x32x16_bf16(PAF(SP,1),VFR(5),o[1],0,0,0), c0,6,SN##0,3); VRDB(5); \
      KRD(GL,2); GAPB(o[0]=__builtin_amdgcn_mfma_f32_32x32x16_bf16(PAF(SP,2),VFR(2),o[0],0,0,0), c0,8,SN##1,0); VRDB(2); \
      KRD(GL,3); GAPB(o[1]=__builtin_amdgcn_mfma_f32_32x32x16_bf16(PAF(SP,2),VFR(6),o[1],0,0,0), c0,10,SN##1,1); VRDB(6); \
      GAPB(o[0]=__builtin_amdgcn_mfma_f32_32x32x16_bf16(PAF(SP,3),VFR(3),o[0],0,0,0), c0,12,SN##1,2); VRDB(3); \
      GAPB(o[1]=__builtin_amdgcn_mfma_f32_32x32x16_bf16(PAF(SP,3),VFR(7),o[1],0,0,0), c0,14,SN##1,3); VRDB(7); \
      GAPB(o[2]=__builtin_amdgcn_mfma_f32_32x32x16_bf16(PAF(SP,0),VFR(0),o[2],0,0,0), c1,0,SN##2,0); \
      GAPB(o[3]=__builtin_amdgcn_mfma_f32_32x32x16_bf16(PAF(SP,0),VFR(4),o[3],0,0,0), c1,2,SN##2,1); \
      GAPB(o[2]=__builtin_amdgcn_mfma_f32_32x32x16_bf16(PAF(SP,1),VFR(1),o[2],0,0,0), c1,4,SN##2,2); \
      GAPB(o[3]=__builtin_amdgcn_mfma_f32_32x32x16_bf16(PAF(SP,1),VFR(5),o[3],0,0,0), c1,6,SN##2,3); \
      GAPB(o[2]=__builtin_amdgcn_mfma_f32_32x32x16_bf16(PAF(SP,2),VFR(2),o[2],0,0,0), c1,8,SN##3,0); \
      GAPB(o[3]=__builtin_amdgcn_mfma_f32_32x32x16_bf16(PAF(SP,2),VFR(6),o[3],0,0,0), c1,10,SN##3,1); \
      GAPB(o[2]=__builtin_amdgcn_mfma_f32_32x32x16_bf16(PAF(SP,3),VFR(3),o[2],0,0,0), c1,12,SN##3,2); \
      GAPB(o[3]=__builtin_amdgcn_mfma_f32_32x32x16_bf16(PAF(SP,3),VFR(7),o[3],0,0,0), c1,14,SN##3,3); \
      l_reg+=sacc; \
    } else { \
    SBAR(); \
      \
    o[0]=__builtin_amdgcn_mfma_f32_32x32x16_bf16(PAF(SP,0),VFR(0),o[0],0,0,0); VRDB(0); float a=MX3(c0[0],c0[1],c1[0]),b=MX3(c0[2],c0[3],c1[1]); a=MX3(a,c1[2],c1[3]); SBAR(); \
    o[1]=__builtin_amdgcn_mfma_f32_32x32x16_bf16(PAF(SP,0),VFR(4),o[1],0,0,0); VRDB(4); a=MX3(a,c0[4],c0[5]);b=MX3(b,c0[6],c0[7]);a=MX3(a,c1[4],c1[5]);b=MX3(b,c1[6],c1[7]); SBAR(); \
    KRD(GL,0); o[0]=__builtin_amdgcn_mfma_f32_32x32x16_bf16(PAF(SP,1),VFR(1),o[0],0,0,0); VRDB(1); a=MX3(a,c0[8],c0[9]);b=MX3(b,c0[10],c0[11]);a=MX3(a,c1[8],c1[9]);b=MX3(b,c1[10],c1[11]); SBAR(); \
    KRD(GL,1); o[1]=__builtin_amdgcn_mfma_f32_32x32x16_bf16(PAF(SP,1),VFR(5),o[1],0,0,0); VRDB(5); a=MX3(a,c0[12],c0[13]);b=MX3(b,c0[14],c0[15]);a=MX3(a,c1[12],c1[13]);b=MX3(b,c1[14],c1[15]); SBAR(); \
    KRD(GL,2); o[0]=__builtin_amdgcn_mfma_f32_32x32x16_bf16(PAF(SP,2),VFR(2),o[0],0,0,0); VRDB(2); \
    float rm=__builtin_fmaxf(a,b); { auto rr=__builtin_amdgcn_permlane32_swap(__float_as_uint(rm),__float_as_uint(rm),false,false); rm=__builtin_fmaxf(__uint_as_float(rr[0]),__uint_as_float(rr[1])); } \
    resc=false; const float rel=rm-mhat;                \
    if(__builtin_expect(__any(rel>(float)THRL),0)){ const float dl=__builtin_fmaxf(rel,0.f); mhat+=dl; \
      const float f=__builtin_amdgcn_exp2f(-dl); l_reg*=f; if(hi==0)wsf[r32]=f; resc=true; } \
    float ref=mhat; asm volatile("":"+v"(ref):"v"(rm));     \
    SBAR(); \
    KRD(GL,3); o[1]=__builtin_amdgcn_mfma_f32_32x32x16_bf16(PAF(SP,2),VFR(6),o[1],0,0,0); VRDB(6); _Pragma("unroll") for(int r=0;r<6;++r){c0[r]=fsub_s(c0[r],ref);c1[r]=fsub_s(c1[r],ref);} SBAR(); \
    o[0]=__builtin_amdgcn_mfma_f32_32x32x16_bf16(PAF(SP,3),VFR(3),o[0],0,0,0); VRDB(3); _Pragma("unroll") for(int r=6;r<11;++r){c0[r]=fsub_s(c0[r],ref);c1[r]=fsub_s(c1[r],ref);} SBAR(); \
    o[1]=__builtin_amdgcn_mfma_f32_32x32x16_bf16(PAF(SP,3),VFR(7),o[1],0,0,0); VRDB(7); _Pragma("unroll") for(int r=11;r<16;++r){c0[r]=fsub_s(c0[r],ref);c1[r]=fsub_s(c1[r],ref);} SBAR(); \
    float sacc=0.f; \
    GAPB4(o[2]=__builtin_amdgcn_mfma_f32_32x32x16_bf16(PAF(SP,0),VFR(0),o[2],0,0,0), c0,0,SN##0,0); \
    GAPB4(o[3]=__builtin_amdgcn_mfma_f32_32x32x16_bf16(PAF(SP,0),VFR(4),o[3],0,0,0), c0,4,SN##0,2); \
    GAPB4(o[2]=__builtin_amdgcn_mfma_f32_32x32x16_bf16(PAF(SP,1),VFR(1),o[2],0,0,0), c0,8,SN##1,0); \
    GAPB4(o[3]=__builtin_amdgcn_mfma_f32_32x32x16_bf16(PAF(SP,1),VFR(5),o[3],0,0,0), c0,12,SN##1,2); \
    GAPB4(o[2]=__builtin_amdgcn_mfma_f32_32x32x16_bf16(PAF(SP,2),VFR(2),o[2],0,0,0), c1,0,SN##2,0); \
    GAPB4(o[3]=__builtin_amdgcn_mfma_f32_32x32x16_bf16(PAF(SP,2),VFR(6),o[3],0,0,0), c1,4,SN##2,2); \
    GAPB4(o[2]=__builtin_amdgcn_mfma_f32_32x32x16_bf16(PAF(SP,3),VFR(3),o[2],0,0,0), c1,8,SN##3,0); \
    GAPB4(o[3]=__builtin_amdgcn_mfma_f32_32x32x16_bf16(PAF(SP,3),VFR(7),o[3],0,0,0), c1,12,SN##3,2); \
    l_reg+=sacc; } \
    }while(0)
  int t=1;
  for(;t+7<NT;t+=2){
    STEP(pa,pb,t,true,true,true);     WAIT_BAR(3); RESC(); ROT();
    STEP(pb,pa,t+1,true,true,true);   WAIT_BAR(3); RESC(); ROT();
  }
  #define ENDW(tt) do{ if((tt)+3<NT){WAIT_BAR(3);} else if((tt)+2<NT){WAIT_BAR(2);} else {WAIT_BAR(0);} }while(0)
  for(;t+1<NT;t+=2){
    STEP(pa,pb,t,(t+3<NT),(t+1<NT),(t+1<NT));       ENDW(t);   RESC(); ROT();
    STEP(pb,pa,t+1,(t+4<NT),(t+2<NT),(t+2<NT));     ENDW(t+1); RESC(); ROT();
  }
  STEP(pa,pb,NT-1,false,false,false); RESC();
  { SBAR(); pv(o,vb0+2*sl_cur,PAF(pb,0),PAF(pb,1),PAF(pb,2),PAF(pb,3)); pv(o+2,vb0+2*sl_cur+8192,PAF(pb,0),PAF(pb,1),PAF(pb,2),PAF(pb,3)); }
  #undef PKW
  #undef PAF
  #undef VFR
  #undef PIN
  #undef MX3
  #undef GAPA
  #undef GAPB
  #undef GAPB4
  #undef EX
  #undef VRD
  #undef VRDB
  #undef KRD
  #undef STEP
  #undef ENDW
  #undef FIX
  {auto rr=__builtin_amdgcn_permlane32_swap(__float_as_uint(l_reg),__float_as_uint(l_reg),false,false);l_reg=__uint_as_float(rr[0])+__uint_as_float(rr[1]);}
  if(hi==0)wsf[32+r32]=l_reg;asm volatile("s_waitcnt lgkmcnt(0)":::"memory");
  float rli[16];
  #pragma unroll
  for(int r=0;r<16;++r)rli[r]=__builtin_amdgcn_rcpf(wsf[32+crow(r,hi)]);
  { bf16*stg=(bf16*)(shm+D2_OST)+wid*4096;
    #pragma unroll
    for(int r=0;r<16;++r){const int orow=crow(r,hi);
      #pragma unroll
      for(int d0=0;d0<4;++d0){ float val=o[d0][r]*rli[r];
        if(EPI==2){ val=__bfloat162float(stg[orow*128+d0*32+r32])-lam*val; }
        stg[orow*128+d0*32+r32]=__float2bfloat16(val);}} }
  asm volatile("s_waitcnt lgkmcnt(0)\n\ts_barrier":::"memory");
  #undef DMA_K
  #undef DMA_V
  #undef RESC
  #undef ROT
}

#ifndef ATT_SEL_DIFF
#define ATT_SEL_DIFF true
#endif
#ifndef ATT_SEL_FOX
#define ATT_SEL_FOX true
#endif
typedef __attribute__((address_space(3))) unsigned ldsu;
struct AttnParams { const bf16* Z; bf16* MIX; const float* logf2; const float* tab; const float* subg; unsigned* counter; const unsigned* nrm; float lam; float osc; };
#define FULL_BAR() asm volatile("s_waitcnt vmcnt(0) lgkmcnt(0)\n\ts_barrier":::"memory")
__device__ __forceinline__ void fox_scan(const float*lf,int n,char*shm){
  ldsf*csl=(ldsf*)(lds_cptr)shm+LDS_CS/4; ldsf*wsum=(ldsf*)(lds_cptr)shm+(LDS_AUX+64)/4;
  int tid_=threadIdx.x; asm volatile("":"+v"(tid_)); const int tid=tid_,lane=tid&63; const int wid=__builtin_amdgcn_readfirstlane(tid>>6);
  const bool act=32*tid<n; float v[32]; float tot=0.f;
  #pragma unroll
  for(int j=0;j<32;++j)v[j]=0.f;
  if(act){ const f32x4a*p=(const f32x4a*)(lf+32*tid);
    #pragma unroll
    for(int k=0;k<8;++k){const f32x4a a=p[k];v[4*k]=a[0];v[4*k+1]=a[1];v[4*k+2]=a[2];v[4*k+3]=a[3];}
    #pragma unroll
    for(int j=0;j<32;++j){tot+=v[j];v[j]=tot;} }
  float inc=tot;
  #pragma unroll
  for(int o=1;o<64;o<<=1){const float tt=shl_(inc,(lane-o)&63,lane); if(lane>=o)inc+=tt;}
  if(lane==63)wsum[wid]=inc;
  FULL_BAR();
  float off=inc-tot;
  for(int w=0;w<wid;++w)off+=wsum[w];
  if(act){
    #pragma unroll
    for(int k=0;k<8;++k){ f32x4a a; a[0]=v[4*k]+off;a[1]=v[4*k+1]+off;a[2]=v[4*k+2]+off;a[3]=v[4*k+3]+off; *(__attribute__((address_space(3))) f32x4a*)(csl+32*tid+4*k)=a; } }
}
__device__ __forceinline__ void diff_table(const float*tab,int h,char*shm){
  ldsf*tb=(ldsf*)(lds_cptr)shm+D2_TBL/4; int i=threadIdx.x; asm volatile("":"+v"(i));
  const int rel=i-447,n=rel<0?-rel:rel;
  const int f=n<8?n:n<12?8:n<16?9:n<23?10:n<32?11:n<46?12:n<64?13:n<91?14:15;
  const int bucket=(rel>0?16:0)+f;
  tb[i]=(i<511)?(tab[bucket*4+h]-tab[15*4+h])*LOG2E:0.f;
}
__device__ __forceinline__ void diff_finish(bf16*Ow,const float*g,float osc,char*shm){
  int tid_=threadIdx.x; asm volatile("":"+v"(tid_)); const int lane=tid_&63; const int wid=__builtin_amdgcn_readfirstlane(tid_>>6);
  const bf16*st=(const bf16*)(shm+D2_OST)+wid*4096;
  const int ch=lane&15; float ga[8];
  #pragma unroll
  for(int j=0;j<8;++j)ga[j]=g[ch*8+j];
  #pragma unroll
  for(int i=0;i<8;++i){ const int row=i*4+(lane>>4);
    const u32x4 a=*(const u32x4*)(st+row*128+ch*8);
    float va[8];
    #pragma unroll
    for(int j=0;j<4;++j){ va[2*j]=__uint_as_float(a[j]<<16); va[2*j+1]=__uint_as_float(a[j]&0xffff0000u); }
    float ss=0.f;
    #pragma unroll
    for(int j=0;j<8;++j)ss+=va[j]*va[j];
    ss+=shx(ss,1,lane);ss+=shx(ss,2,lane);ss+=shx(ss,4,lane);ss+=shx(ss,8,lane);
    const float r=osc/sqrtf(ss*(1.f/128.f)+1e-5f);
    u32x4 oa;
    #pragma unroll
    for(int j=0;j<4;++j)oa[j]=cvtpk_s(va[2*j]*r*ga[2*j],va[2*j+1]*r*ga[2*j+1]);
    *(u32x4*)(Ow+(long)row*OP+ch*8)=oa; }
}
template<int THRL> __device__ __forceinline__ void attn_phase(char*lds,const AttnParams&P){
  const int tid=threadIdx.x; const int wid=__builtin_amdgcn_readfirstlane(tid>>6);
  volatile ldsu*qw=(volatile ldsu*)(lds_cptr)lds+LDS_AUX/4;
  #define GRAB(dst) do{ if(tid==0){ *qw=atomicAdd(P.counter,1u); } FULL_BAR(); dst=__builtin_amdgcn_readfirstlane((int)*qw); }while(0)
  int idx; GRAB(idx);
  while(ATT_SEL_DIFF&&idx<512){ const int qb=63-(idx>>3),bh=idx&7,b=bh>>2,h=bh&3;
    const bf16*zb=P.Z+(long)b*SEQ*ZP;
    diff_table(P.tab,h,lds);
    float bmax=0.f;
    for(int i=0;i<32;++i)bmax=fmaxf(bmax,fabsf(P.tab[i*4+h]-P.tab[60+h])*LOG2E);
    for(int mp=0;mp<2;++mp){
      const unsigned*nq=P.nrm+((2*2+b)*8+2*h+mp)*2,*nk=P.nrm+((3*2+b)*8+2*h+mp)*2;
      const float nq2=__uint_as_float(nq[0])+__uint_as_float(nq[1]),nk2=__uint_as_float(nk[0])+__uint_as_float(nk[1]);
      const float bound=1.02f*sqrtf(nq2*nk2)+bmax;
      const int fast=__builtin_amdgcn_readfirstlane(bound<60.f?1:0);
      if(fast) attn_unit2<THRL,true>(qb,zb+1536+h*128+mp*64,zb+2048+h*128+mp*64,zb+2560+h*128,lds,mp?2:1,P.lam);
      else     attn_unit2<THRL,false>(qb,zb+1536+h*128+mp*64,zb+2048+h*128+mp*64,zb+2560+h*128,lds,mp?2:1,P.lam); }
    diff_finish(P.MIX+((long)b*SEQ+qb*QB+wid*QBLK)*OP+512+h*128,P.subg,P.osc,lds);
    GRAB(idx);
  }
  while(ATT_SEL_FOX&&idx<1536){ const int j=idx-512,qb=63-(j>>4),bh=j&15,b=bh>>3,h=bh&7;
    const bf16*zb=P.Z+(long)b*SEQ*ZP;
    fox_scan(P.logf2+(long)(b*8+h)*SEQ,256*(qb+1),lds);
    { int tid_=threadIdx.x; asm volatile("":"+v"(tid_)); const int ln=tid_&63,row=tid_>>1,hf=tid_&1;
      const u32x4*qp=(const u32x4*)(zb+h*64+(long)(256*qb+row)*ZP+hf*32),*kp=(const u32x4*)(zb+512+h*64+(long)(256*qb+row)*ZP+hf*32);
      float dot=0.f,qq=0.f;
      #pragma unroll
      for(int i=0;i<4;++i){ const u32x4 a=qp[i],c=kp[i];
        #pragma unroll
        for(int j=0;j<4;++j){ const float q0_=__uint_as_float(a[j]<<16),q1_=__uint_as_float(a[j]&0xffff0000u),k0_=__uint_as_float(c[j]<<16),k1_=__uint_as_float(c[j]&0xffff0000u);
          dot+=q0_*k0_+q1_*k1_; qq+=q0_*q0_+q1_*q1_; } }
      dot+=shx(dot,1,ln); qq+=shx(qq,1,ln);
      #pragma unroll
      for(int o=2;o<64;o<<=1){ dot=fminf(dot,shx(dot,o,ln)); qq=fmaxf(qq,shx(qq,o,ln)); }
      ldsf*st=(ldsf*)(lds_cptr)lds+(LDS_AUX+128)/4; if(ln==0){ st[wid]=dot; st[8+wid]=qq; } }
    FULL_BAR();
    int kt0=0,fastfox=0;
    { const unsigned*nk=P.nrm+((1*2+b)*8+h)*2; cldsf*st=(cldsf*)(lds_cptr)lds+(LDS_AUX+128)/4;
      float dmin=st[0],nq2=st[8];
      #pragma unroll
      for(int w=1;w<8;++w){ dmin=fminf(dmin,st[w]); nq2=fmaxf(nq2,st[8+w]); }
      const float nk2=__uint_as_float(nk[0])+__uint_as_float(nk[1]);
      const float nqk=1.02f*sqrtf(nq2*nk2); fastfox=__builtin_amdgcn_readfirstlane(nqk<60.f?1:0);
      const float thr=nqk-dmin+32.5f;
      cldsf*csl=(cldsf*)(lds_cptr)lds+LDS_CS/4; const float cq=csl[256*qb];
      int lo_=0,hi_=4*qb;
      while(lo_<hi_){ const int mid=(lo_+hi_)>>1; if(csl[64*mid+63]-cq>thr)lo_=mid+1; else hi_=mid; }
      kt0=__builtin_amdgcn_readfirstlane(lo_)&~1; }
    if(fastfox) attn_unit<0,2*THRL,true>(qb,kt0,zb+h*64,zb+512+h*64,zb+1024+h*64,P.MIX+(long)b*SEQ*OP+h*64,lds,0,LDS_OST,0.f);
    else        attn_unit<0,2*THRL,false>(qb,kt0,zb+h*64,zb+512+h*64,zb+1024+h*64,P.MIX+(long)b*SEQ*OP+h*64,lds,0,LDS_OST,0.f);
    GRAB(idx);
  }
  #undef GRAB
}
#undef FULL_BAR
#undef SBAR
#undef WAIT_BAR
}
#include <hip/hip_cooperative_groups.h>
namespace cg = cooperative_groups;
#ifndef MK_ONE_LAUNCH
#define MK_ONE_LAUNCH 1
#endif
constexpr int NWAVES = 8;
#ifndef MK_MSPLIT
#define MK_MSPLIT 2
#endif
constexpr int MSPLIT = MK_MSPLIT;
constexpr int BATCH = 2, T = 16384, D = 1024, FF = 4096, M = BATCH * T, NIN = 3328, NINSRC = 3080, DEPTH = 2;
constexpr size_t MiB = 1u << 20;
constexpr size_t WS_CTL = 0, CTL_ZERO_BYTES = 65536;
constexpr int CW_BAR = 4096, CW_NRM = 1024;
constexpr size_t WS_WIN = 2 * MiB, WIN_BYTES = (size_t)NIN * D * 2;
constexpr size_t WS_WO = 16 * MiB, WO_BYTES = (size_t)D * D * 2;
constexpr size_t WS_W1 = 20 * MiB, W1_BYTES = (size_t)D * FF * 2;
constexpr size_t WS_W2 = 36 * MiB, W2_BYTES = (size_t)D * FF * 2;
constexpr size_t WS_SSQ = 52 * MiB;
constexpr size_t WS_DUMP = 56 * MiB;
constexpr size_t WS_LOGF = 54 * MiB;
constexpr size_t WS_XB = 64 * MiB;
constexpr size_t WS_MIX = 128 * MiB;
constexpr size_t WS_Z = 192 * MiB;
constexpr size_t WS_H = 128 * MiB;
constexpr size_t WS_END = 384 * MiB;
static_assert(WS_WIN + 2 * WIN_BYTES <= WS_WO && WS_WO + 2 * WO_BYTES <= WS_W1 && WS_W1 + 2 * W1_BYTES <= WS_W2 && WS_W2 + 2 * W2_BYTES <= WS_SSQ, "ws map");
static_assert(WS_H + (size_t)M * FF * 2 <= WS_END && WS_Z + (size_t)M * 3072 * 2 <= WS_END, "ws map 2");
constexpr int RING_BYTES = 131072, EPI_LDS_OFF = RING_BYTES;
constexpr int PARAM_OFF = (attn_body::LDS_TOTAL > RING_BYTES + 4096) ? attn_body::LDS_TOTAL : RING_BYTES + 4096;
constexpr int XB_ST_OFF = PARAM_OFF + 192;
constexpr int LDS_BYTES = PARAM_OFF + 256;
constexpr int RTAB_OFF = RING_BYTES + 4096 + 256;
static_assert(RTAB_OFF + 8 * 256 * 4 <= PARAM_OFF, "rstd table");
static_assert(LDS_BYTES <= 160 * 1024, "LDS");

#define LAS __attribute__((address_space(3)))
typedef unsigned short bf16;
typedef unsigned v4u __attribute__((ext_vector_type(4)));
typedef float f32x4 __attribute__((ext_vector_type(4)));
__device__ __forceinline__ unsigned f2bf(float f) { unsigned u = __builtin_bit_cast(unsigned, f); return (u + 0x7fffu + ((u >> 16) & 1u)) >> 16; }
__device__ __forceinline__ unsigned pk2(float lo, float hi) { return f2bf(lo) | (f2bf(hi) << 16); }
__device__ __forceinline__ float wave_sum(float v, int lane) {
#pragma unroll
    for (int o = 1; o < 64; o <<= 1) v += shx(v, o, lane);
    return v;
}
template <bool MAPIN>
__device__ __forceinline__ void p0_transpose_item(const float* W, int K, int Nsrc, int nblk, const float* gain, bf16* WT, LAS float* scr, int item, int lane) {
    const int kb = __builtin_amdgcn_readfirstlane(item / nblk), nb = __builtin_amdgcn_readfirstlane(item % nblk), k0 = 64 * kb, n0 = 32 * nb;
    const int ch = lane & 7, rr = lane >> 3;
    const int nn = n0 + 4 * ch;
    int src = nn; if (MAPIN) src = nn < 1536 ? nn : (nn < 3072 ? nn + 8 : (nn < 3080 ? nn - 1536 : -1));
    f32x4 v[8];
#pragma unroll
    for (int i = 0; i < 8; ++i) { const int kk = 8 * i + rr; v[i] = (f32x4){0.f, 0.f, 0.f, 0.f}; if (src >= 0) v[i] = __builtin_nontemporal_load((const f32x4*)(W + (size_t)(k0 + kk) * Nsrc + src)); }
#pragma unroll
    for (int i = 0; i < 8; ++i) { const int kk = 8 * i + rr; f32x4 w = v[i]; if (gain) w = w * gain[k0 + kk];
        scr[kk * 33 + 4 * ch + 0] = w[0]; scr[kk * 33 + 4 * ch + 1] = w[1]; scr[kk * 33 + 4 * ch + 2] = w[2]; scr[kk * 33 + 4 * ch + 3] = w[3]; }
    asm volatile("s_waitcnt lgkmcnt(0)" ::: "memory");
    const int c = lane & 7;
#pragma unroll
    for (int j = 0; j < 4; ++j) { const int n = (lane >> 3) + 8 * j; const LAS float* s = scr + (8 * c) * 33 + n;
        v4u o; o.x = pk2(s[0 * 33], s[1 * 33]); o.y = pk2(s[2 * 33], s[3 * 33]); o.z = pk2(s[4 * 33], s[5 * 33]); o.w = pk2(s[6 * 33], s[7 * 33]);
        *(v4u*)(WT + (size_t)(n0 + n) * K + k0 + 8 * c) = o; }
    asm volatile("s_waitcnt lgkmcnt(0)" ::: "memory");
}

#define XB_TMO      128
#define XB_XCNT(j)  (256  + 64 * (j))
#define XB_XSUB(j)  (1280 + 64 * (j))
#define XB_XGEN(j)  (2304 + 64 * (j))
#define XB_TOP      3328
#define XB_TOPGEN   3392
#define XCD_BAR_WORDS 3456
#define XB_SPIN_CAP (1u << 18)

__device__ __forceinline__ unsigned xb_ld(unsigned* p)              { return __hip_atomic_load(p, __ATOMIC_RELAXED, __HIP_MEMORY_SCOPE_AGENT); }
__device__ __forceinline__ unsigned xb_add(unsigned* p, unsigned v) { return __hip_atomic_fetch_add(p, v, __ATOMIC_RELAXED, __HIP_MEMORY_SCOPE_AGENT); }
__device__ __forceinline__ unsigned xb_xcc_id() { return (unsigned)__builtin_amdgcn_s_getreg((3 << 11) | 20) & 0xFu; }
#define XB_SPIN(cond, bar) do { unsigned _sp = 0; while (cond) { __builtin_amdgcn_s_sleep(1); \
    if ((++_sp & 255u) == 0u) { if (xb_ld(&(bar)[XB_TMO])) break; if (_sp > XB_SPIN_CAP) { atomicAdd(&(bar)[XB_TMO], 1u); break; } } } } while (0)

struct XcdBarrier {
    unsigned* bar; unsigned x;
    volatile LAS unsigned* st;
};

__device__ __forceinline__ XcdBarrier xcd_barrier_post(unsigned* bar, volatile LAS unsigned* st) {
    XcdBarrier b; b.bar = bar; b.x = xb_xcc_id(); b.st = st;
    if (threadIdx.x == 0) (void)xb_add(&bar[XB_XCNT(b.x)], 1u);
    return b;
}
__device__ __forceinline__ void xcd_barrier_complete(unsigned* bar, unsigned x, unsigned& nloc, unsigned& nx) {
    const unsigned G = gridDim.x * gridDim.y * gridDim.z;
    unsigned sum, cnt, mine, sp = 0u;
    for (;;) {
        sum = 0u; cnt = 0u; mine = 0u;
#pragma unroll
        for (unsigned j = 0; j < 16; ++j) { const unsigned c = xb_ld(&bar[XB_XCNT(j)]); sum += c; cnt += (c > 0u) ? 1u : 0u; mine = (j == x) ? c : mine; }
        if (sum == G) break;
        __builtin_amdgcn_s_sleep(1);
        if ((++sp & 255u) == 0u) { if (xb_ld(&bar[XB_TMO])) break; if (sp > XB_SPIN_CAP) { atomicAdd(&bar[XB_TMO], 1u); break; } }
    }
    nloc = mine > 0u ? mine : 1u; nx = cnt > 0u ? cnt : 1u;
}

__device__ __forceinline__ void xcd_barrier(const XcdBarrier& b) {
    asm volatile("s_waitcnt vmcnt(0)" ::: "memory");
    __syncthreads();
    if (threadIdx.x == 0) {
        unsigned* bar = b.bar;
        __builtin_amdgcn_s_waitcnt(0);
        unsigned nloc = b.st[0], nx = b.st[1];
        if (nloc == 0u) { xcd_barrier_complete(bar, b.x, nloc, nx); b.st[0] = nloc; b.st[1] = nx; }
        const unsigned old = xb_add(&bar[XB_XSUB(b.x)], 1u);
        const unsigned gen = old / nloc;
        if (old + 1u == (gen + 1u) * nloc) {
            __builtin_amdgcn_fence(__ATOMIC_RELEASE, "agent");
            asm volatile("s_waitcnt vmcnt(0)" ::: "memory");
            const unsigned og = xb_add(&bar[XB_TOP], 1u);
            const unsigned tg = og / nx;
            if (og + 1u == (tg + 1u) * nx) xb_add(&bar[XB_TOPGEN], 1u);
            else XB_SPIN(xb_ld(&bar[XB_TOPGEN]) == tg, bar);
            __builtin_amdgcn_fence(__ATOMIC_ACQUIRE, "agent");
            xb_add(&bar[XB_XGEN(b.x)], 1u);
            asm volatile("s_waitcnt vmcnt(0)" ::: "memory");
        } else {
            XB_SPIN(xb_ld(&bar[XB_XGEN(b.x)]) == gen, bar);
            __builtin_amdgcn_fence(__ATOMIC_ACQUIRE, "agent");
            asm volatile("s_waitcnt vmcnt(0)" ::: "memory");
        }
    }
    __syncthreads();
}

__device__ __forceinline__ int opqv(int v) { asm volatile("" : "+v"(v)); return v; }
__device__ __forceinline__ int opq(int v) { asm volatile("" : "+s"(v)); return v; }
__device__ __forceinline__ const float* ldprm(LAS unsigned char* l, int i) {
    volatile LAS unsigned* p = (volatile LAS unsigned*)(l + PARAM_OFF) + 2 * i; unsigned a = p[0], b = p[1];
    a = __builtin_amdgcn_readfirstlane(a); b = __builtin_amdgcn_readfirstlane(b);
    return (const float*)(const __attribute__((address_space(1))) float*)(((unsigned long long)b << 32) | a);
}
struct Args { const float* in[15]; float* out; unsigned char* ws; int ph_lo, ph_hi; };
__global__ void __launch_bounds__(NWAVES * 64, 2) fwd_megakernel(Args args) {
    extern __shared__ __attribute__((aligned(16))) unsigned char lds[];
    LAS unsigned char* ldsl = (LAS unsigned char*)lds;
    const int tid = threadIdx.x, wave = __builtin_amdgcn_readfirstlane(tid >> 6);
#define lane (opqv((int)threadIdx.x) & 63)
    const int G = gridDim.x;
    if (tid == 0) { volatile LAS unsigned long long* pp = (volatile LAS unsigned long long*)(ldsl + PARAM_OFF);
#pragma unroll
        for (int i = 0; i < 15; ++i) pp[i] = (unsigned long long)args.in[i];
        pp[15] = (unsigned long long)args.out; pp[16] = (unsigned long long)args.ws;
        ((volatile LAS unsigned*)(ldsl + XB_ST_OFF))[0] = 0u; ((volatile LAS unsigned*)(ldsl + XB_ST_OFF))[1] = 0u; }
    __syncthreads();
    (void)xcd_barrier_post((unsigned*)(args.ws + WS_CTL) + CW_BAR, (volatile LAS unsigned*)(ldsl + XB_ST_OFF));
#define INP(i) ldprm(ldsl, (i))
#define OUTP ((float*)ldprm(ldsl, 15))
#define WSP ((unsigned char*)ldprm(ldsl, 16))
#define XB ((bf16*)(ws + WS_XB))
#define MIX ((bf16*)(ws + WS_MIX))
#define Z ((bf16*)(ws + WS_Z))
#define HB ((bf16*)(ws + WS_H))
#define SSQ ((float*)(ws + WS_SSQ))
#define LOGF ((float*)(ws + WS_LOGF))
    const int lo = args.ph_lo, hi = args.ph_hi;
#ifndef PHMASK
#define PHMASK 0xfff
#endif
#define IN(k) (((PHMASK >> ((k) > 5 && (k) < 11 ? (k) - 5 : (k))) & 1) && lo <= (k) && (k) < hi)
#ifndef DUPMASK
#define DUPMASK 0
#endif
#define REPS(bit) ((((DUPMASK) >> (bit)) & 1) + 1)
#define XBAR() do { XcdBarrier xb_; xb_.bar = (unsigned*)(WSP + WS_CTL) + CW_BAR; xb_.x = xb_xcc_id(); xb_.st = (volatile LAS unsigned*)(ldsl + XB_ST_OFF); xcd_barrier(xb_); } while (0)
#define SEAM(k) do { if (IN(k) && IN((k) + 1)) { if (lo < 0) cg::this_grid().sync(); else { XcdBarrier xb_; xb_.bar = (unsigned*)(WSP + WS_CTL) + CW_BAR; xb_.x = xb_xcc_id(); xb_.st = (volatile LAS unsigned*)(ldsl + XB_ST_OFF); xcd_barrier(xb_); } } } while (0)

    if (IN(0)) {
        LAS float* scr = (LAS float*)(ldsl + wave * 16384); unsigned char* ws = WSP; const float* x_in = INP(0);
        const float *w_in = INP(1), *w_out = INP(8), *g_att = INP(9), *g_mlp = INP(10), *w_1 = INP(11), *w_2 = INP(12);
        const int gw = blockIdx.x * NWAVES + wave, NGW = G * NWAVES;
        constexpr int I_IN = (D / 64) * (NIN / 32), I_O = (D / 64) * (D / 32), I_1 = (D / 64) * (FF / 32), I_2 = (FF / 64) * (D / 32), I_L = I_IN + I_O + I_1 + I_2;
        for (int it = gw; it < DEPTH * I_L; it += NGW) {
            const int l = __builtin_amdgcn_readfirstlane(it / I_L); int r = __builtin_amdgcn_readfirstlane(it % I_L);
            if (r < I_IN) { p0_transpose_item<true>(w_in + (size_t)l * D * NINSRC, D, NINSRC, NIN / 32, g_att + l * D, (bf16*)(ws + WS_WIN + l * WIN_BYTES), scr, r, lane); continue; } r -= I_IN;
            if (r < I_O) { p0_transpose_item<false>(w_out + (size_t)l * D * D, D, D, D / 32, nullptr, (bf16*)(ws + WS_WO + l * WO_BYTES), scr, r, lane); continue; } r -= I_O;
            if (r < I_1) { p0_transpose_item<false>(w_1 + (size_t)l * D * FF, D, FF, FF / 32, g_mlp + l * D, (bf16*)(ws + WS_W1 + l * W1_BYTES), scr, r, lane); continue; } r -= I_1;
            p0_transpose_item<false>(w_2 + (size_t)l * FF * D, FF, D, D / 32, nullptr, (bf16*)(ws + WS_W2 + l * W2_BYTES), scr, r, lane);
        }
        for (int m0 = gw * 4; m0 < M; m0 += NGW * 4) {
            const int ln = lane; f32x4 v[4][4]; float s[4];
#pragma unroll
            for (int q = 0; q < 4; ++q) { const f32x4* xr = (const f32x4*)(x_in + (size_t)(m0 + q) * D) + ln;
#pragma unroll
                for (int j = 0; j < 4; ++j) v[q][j] = __builtin_nontemporal_load(xr + 64 * j); }
#pragma unroll
            for (int q = 0; q < 4; ++q) { float a = 0.f;
#pragma unroll
                for (int j = 0; j < 4; ++j) a += (v[q][j][0] * v[q][j][0] + v[q][j][1] * v[q][j][1]) + (v[q][j][2] * v[q][j][2] + v[q][j][3] * v[q][j][3]);
                s[q] = wave_sum(a, ln); }
#pragma unroll
            for (int q = 0; q < 4; ++q) { unsigned long long* o8 = (unsigned long long*)(XB + (size_t)(m0 + q) * D) + ln;
#pragma unroll
                for (int j = 0; j < 4; ++j) o8[64 * j] = (unsigned long long)pk2(v[q][j][0], v[q][j][1]) | ((unsigned long long)pk2(v[q][j][2], v[q][j][3]) << 32);
                if (ln == 0) *(f32x4*)(SSQ + (size_t)(m0 + q) * 4) = (f32x4){s[q], 0.f, 0.f, 0.f}; }
        }
    }
    SEAM(0);
    for (int l = 0; l < DEPTH; ++l) {
        const int pb = 1 + 5 * l;
        for (int rp = 0; rp < REPS(1); ++rp) { if (rp) cg::this_grid().sync();
        if (IN(pb)) { unsigned char* ws = WSP;
            pg8::Gemm g{XB, (const bf16*)(ws + WS_WIN + l * WIN_BYTES), M, 3072, D}; pg8::StaticOrder S; S.init(M, 3072, G, opq((int)blockIdx.x));
            { LAS float* rt = (LAS float*)(ldsl + RTAB_OFF); pg8::Unit uu;
              for (int i = __builtin_amdgcn_readfirstlane(opqv((int)threadIdx.x) >> 8); S.next(i, uu); i += 2) { const int r = opqv((int)threadIdx.x) & 255; rt[i * 256 + r] = pg8::row_rstd(SSQ, uu.pm * 256 + r); }
              __syncthreads(); }
            pg8::EpiInProj E{Z, (const LAS float*)(ldsl + RTAB_OFF), SSQ, INP(2) + l * 8, LOGF, (unsigned*)(ws + WS_CTL) + CW_NRM + 128 * l};
            pg8::gemm_phase<pg8::EpiInProj, pg8::StaticOrder, true, true>(ldsl, g, S, E);
            { const int ln = lane, row = ln & 15, quad = ln >> 4; const float* bfp = INP(2) + l * 8; const bf16* wf = (const bf16*)(ws + WS_WIN + l * WIN_BYTES) + (size_t)(3072 + row) * D + quad * 8;
              for (int rb = opq((int)blockIdx.x) * NWAVES + wave; rb < M / 16; rb += G * NWAVES) {
                const int m0 = rb * 16; const bf16* ap = XB + (size_t)(m0 + row) * D + quad * 8; pg8::f32x4 acc = {0.f, 0.f, 0.f, 0.f};
#pragma unroll 8
                for (int k0 = 0; k0 < D; k0 += 32) acc = __builtin_amdgcn_mfma_f32_16x16x32_bf16(*(const pg8::bf16x8*)(ap + k0), *(const pg8::bf16x8*)(wf + k0), acc, 0, 0, 0);
                if (row < 8) {
#pragma unroll
                    for (int rg = 0; rg < 4; ++rg) { const int m = m0 + quad * 4 + rg; const float z = acc[rg] * pg8::row_rstd(SSQ, m) + bfp[row];
                        const float ls = fminf(z, 0.f) - log1pf(expf(-fabsf(z)));
                        LOGF[(size_t)((m >> 14) * 8 + row) * T + (m & (T - 1))] = ls * 1.4426950408889634f; } } } }
        } }
        SEAM(pb);
        for (int rp = 0; rp < REPS(2); ++rp) { if (rp) cg::this_grid().sync();
        if (IN(pb + 1)) { unsigned char* ws = WSP;
            float d1 = INP(3)[l * 64 + lane] * INP(4)[l * 64 + lane], d2 = INP(5)[l * 64 + lane] * INP(6)[l * 64 + lane];
            d1 = wave_sum(d1, lane); d2 = wave_sum(d2, lane);
            const float li = 0.8f - 0.6f * expf(-0.3f * (float)l);
            attn_body::AttnParams P{(const attn_body::bf16*)Z, (attn_body::bf16*)MIX, LOGF, INP(13), INP(7) + l * 128, (unsigned*)(ws + WS_CTL) + 64 * (1 + l) + 16 * rp, (const unsigned*)(ws + WS_CTL) + CW_NRM + 128 * l, expf(d1) - expf(d2) + li, 1.0f - li};
            attn_body::attn_phase<8>((char*)lds, P);
        } }
        SEAM(pb + 1);
        if (IN(pb + 2)) { unsigned char* ws = WSP; float* out = OUTP;
            pg8::Gemm g{MIX, (const bf16*)(ws + WS_WO + l * WO_BYTES), M, D, D}; pg8::StaticOrder S; S.init(M, D, G, opq((int)blockIdx.x));
            pg8::EpiResid E{XB, SSQ, (LAS float*)(ldsl + EPI_LDS_OFF)};
            pg8::gemm_phase<pg8::EpiResid, pg8::StaticOrder, true, true>(ldsl, g, S, E);
        }
        SEAM(pb + 2);
        if (IN(pb + 3)) {
            for (int hf = 0; hf < MSPLIT; ++hf) { unsigned char* ws = WSP; const size_t r0 = (size_t)opq(hf * (M / MSPLIT));
                { pg8::Gemm g{XB + r0 * D, (const bf16*)(ws + WS_W1 + l * W1_BYTES), M / MSPLIT, FF, D}; pg8::StaticOrder S; S.init(M / MSPLIT, FF, G, opq((int)blockIdx.x));
                  { LAS float* rt = (LAS float*)(ldsl + RTAB_OFF); pg8::Unit uu;
                    for (int i = __builtin_amdgcn_readfirstlane(opqv((int)threadIdx.x) >> 8); S.next(i, uu); i += 2) { const int r = opqv((int)threadIdx.x) & 255; rt[i * 256 + r] = pg8::row_rstd(SSQ + r0 * 4, uu.pm * 256 + r); }
                    __syncthreads(); }
                  pg8::EpiRelu2 E{HB, (const LAS float*)(ldsl + RTAB_OFF)};
                  pg8::gemm_phase<pg8::EpiRelu2, pg8::StaticOrder, true, true>(ldsl, g, S, E); }
                XBAR();
                { pg8::Gemm g{HB, (const bf16*)(ws + WS_W2 + l * W2_BYTES), M / MSPLIT, D, FF}; pg8::StaticOrder S; S.init(M / MSPLIT, D, G, opq((int)blockIdx.x));
                  pg8::EpiResid E{XB + r0 * D, SSQ + r0 * 4, (LAS float*)(ldsl + EPI_LDS_OFF)};
                  pg8::gemm_phase<pg8::EpiResid, pg8::StaticOrder, true, true>(ldsl, g, S, E); }
                XBAR();
            }
        }
    }
    if (IN(11)) { float* out = OUTP; unsigned char* ws = WSP;
        const int gw = blockIdx.x * NWAVES + wave, NGW = G * NWAVES; const int ln = lane;
        f32x4 gv[2][2];
#pragma unroll
        for (int j = 0; j < 2; ++j) { gv[j][0] = *(const f32x4*)(INP(14) + 8 * (ln + 64 * j)); gv[j][1] = *(const f32x4*)(INP(14) + 8 * (ln + 64 * j) + 4); }
        for (int m0 = gw * 4; m0 < M; m0 += NGW * 4) {
            v4u v[4][2]; f32x4 q[4];
#pragma unroll
            for (int r = 0; r < 4; ++r) { const v4u* xr = (const v4u*)(XB + (size_t)(m0 + r) * D) + ln; v[r][0] = xr[0]; v[r][1] = xr[64]; q[r] = *(const f32x4*)(SSQ + (size_t)(m0 + r) * 4); }
#pragma unroll
            for (int r = 0; r < 4; ++r) { const float rs = 1.0f / sqrtf(((q[r][0] + q[r][1]) + (q[r][2] + q[r][3])) * (1.0f / D) + 1e-5f);
#pragma unroll
                for (int j = 0; j < 2; ++j) { const v4u w = v[r][j];
                    const f32x4 a = {__builtin_bit_cast(float, w.x << 16), __builtin_bit_cast(float, w.x & 0xffff0000u), __builtin_bit_cast(float, w.y << 16), __builtin_bit_cast(float, w.y & 0xffff0000u)};
                    const f32x4 b = {__builtin_bit_cast(float, w.z << 16), __builtin_bit_cast(float, w.z & 0xffff0000u), __builtin_bit_cast(float, w.w << 16), __builtin_bit_cast(float, w.w & 0xffff0000u)};
                    f32x4* o = (f32x4*)(out + (size_t)(m0 + r) * D + 8 * (ln + 64 * j)); __builtin_nontemporal_store(a * rs * gv[j][0], o); __builtin_nontemporal_store(b * rs * gv[j][1], o + 1); } }
        }
    }
#undef IN
#undef SEAM
#undef XBAR
}

extern "C" void kernel_launch(void* const* d_in, const int* in_sizes, int n_in, void* d_out, int out_size, void* d_ws, size_t ws_size, hipStream_t stream) {
    static int grid = 0;
    if (grid == 0) {
        if (n_in != 15 || in_sizes[0] != M * D || out_size != M * D || ws_size < WS_END) { fprintf(stderr, "kernel_launch: unexpected shapes / workspace (n_in %d, ws %zu)\n", n_in, ws_size); grid = -1; return; }
        int dev = 0, cus = 0, per_cu = 0;
        hipGetDevice(&dev); hipDeviceGetAttribute(&cus, hipDeviceAttributeMultiprocessorCount, dev);
        if (hipFuncSetAttribute((const void*)fwd_megakernel, hipFuncAttributeMaxDynamicSharedMemorySize, LDS_BYTES) != hipSuccess) { fprintf(stderr, "kernel_launch: hipFuncSetAttribute failed\n"); grid = -1; return; }
        hipOccupancyMaxActiveBlocksPerMultiprocessor(&per_cu, (const void*)fwd_megakernel, NWAVES * 64, LDS_BYTES);
        (void)hipGetLastError();
        if (per_cu < 1) per_cu = 1;
        grid = cus * per_cu;
        fprintf(stderr, "kernel_launch: grid %d (%d CUs x %d)\n", grid, cus, per_cu);
    }
    if (grid < 0) return;
    hipMemsetAsync((char*)d_ws + WS_CTL, 0, CTL_ZERO_BYTES, stream);
    Args a{};
    for (int i = 0; i < 15; ++i) a.in[i] = (const float*)d_in[i];
    a.out = (float*)d_out; a.ws = (unsigned char*)d_ws;
#if MK_ONE_LAUNCH
    a.ph_lo = 0; a.ph_hi = 12;
    void* kargs[] = {&a};
    hipError_t e = hipLaunchCooperativeKernel((const void*)fwd_megakernel, dim3(grid), dim3(NWAVES * 64), kargs, LDS_BYTES, stream);
    if (e != hipSuccess) fprintf(stderr, "cooperative launch failed: %s (grid %d)\n", hipGetErrorString(e), grid);
#else
    for (int p = 0; p < 12; ++p) { a.ph_lo = p; a.ph_hi = p + 1; hipLaunchKernelGGL(fwd_megakernel, dim3(grid), dim3(NWAVES * 64), LDS_BYTES, stream, a); }
#endif
}
```
